# Optimizing an MI355X kernel written in HIP

```python
import math
import jax, jax.numpy as jnp
from jax import lax
import numpy as np

D_MODEL = 1024
BATCH = 8
SEQ = 2048
DEPTH = 4

MEM_LEN = 256
CONV_WIDTH = D_MODEL
CONV_K = 3
DIFF_HEADS = 8
DIFF_DK = 64
DIFF_DV = 2 * DIFF_DK
DIFF_Q = DIFF_HEADS * 2 * DIFF_DK
DIFF_V = DIFF_HEADS * DIFF_DV
MEM_HEADS = 4
MEM_DH = 256
MEM_W = MEM_HEADS * MEM_DH
N_BRANCH = 3
D_FF = 4 * D_MODEL
REL_BUCKETS = 32
REL_MAX_DIST = 128
Q_BLOCK = 128
LN_EPS = 1e-5
DEEPNORM_ALPHA = (2 * DEPTH) ** 0.25
DEEPNORM_BETA = (8 * DEPTH) ** -0.25
IN_GROUPS = [CONV_WIDTH, CONV_WIDTH, CONV_WIDTH, DIFF_Q, DIFF_Q, DIFF_V, MEM_W, N_BRANCH * D_MODEL]
N_IN = sum(IN_GROUPS)
IN_SPLITS = [int(v) for v in np.cumsum(IN_GROUPS)[:-1]]

kernel_name = 'hybrid_conv_diffattn_memory_encoder'


def layer_norm(x, g, b):
    xf = x.astype(jnp.float32)
    mu = jnp.mean(xf, axis=-1, keepdims=True)
    var = jnp.mean(jnp.square(xf - mu), axis=-1, keepdims=True)
    return ((xf - mu) * lax.rsqrt(var + LN_EPS) * g + b).astype(x.dtype)


def rms_norm(x, g):
    xf = x.astype(jnp.float32)
    return (xf * lax.rsqrt(jnp.mean(xf * xf, axis=-1, keepdims=True) + LN_EPS) * g).astype(x.dtype)


def t5_bucket(rel):
    nb = REL_BUCKETS // 2
    max_exact = nb // 2
    ret = (rel > 0).astype(jnp.int32) * nb
    n = jnp.abs(rel)
    nf = jnp.maximum(n, 1).astype(jnp.float32)
    large = max_exact + (jnp.log(nf / max_exact) / math.log(REL_MAX_DIST / max_exact)
                         * (nb - max_exact)).astype(jnp.int32)
    large = jnp.minimum(large, nb - 1)
    return ret + jnp.where(n < max_exact, n, large)


def diff_attention(q1, q2, k1, k2, v, rel_bias, lam):
    B, S, H, DK = q1.shape
    nblk = S // Q_BLOCK
    scale = DIFF_DK ** -0.5
    qb1 = (q1 * scale).reshape(B, nblk, Q_BLOCK, H, DK).transpose(1, 0, 2, 3, 4)
    qb2 = (q2 * scale).reshape(B, nblk, Q_BLOCK, H, DK).transpose(1, 0, 2, 3, 4)
    kpos = jnp.arange(S, dtype=jnp.int32)

    def one_block(args):
        i, qa, qb = args
        qpos = i * Q_BLOCK + jnp.arange(Q_BLOCK, dtype=jnp.int32)
        bucket = t5_bucket(kpos[None, :] - qpos[:, None])
        bias = jnp.take(rel_bias, bucket, axis=0).transpose(2, 0, 1).astype(jnp.float32)
        s1 = jnp.einsum('bqhd,bkhd->bhqk', qa, k1).astype(jnp.float32) + bias[None]
        s2 = jnp.einsum('bqhd,bkhd->bhqk', qb, k2).astype(jnp.float32) + bias[None]
        p = jax.nn.softmax(s1, axis=-1) - lam * jax.nn.softmax(s2, axis=-1)
        return jnp.einsum('bhqk,bkhd->bqhd', p.astype(v.dtype), v)

    out = lax.map(one_block, (jnp.arange(nblk, dtype=jnp.int32), qb1, qb2))
    return out.transpose(1, 0, 2, 3, 4).reshape(B, S, H, v.shape[-1])


def token_mix(x, mem, w_in, b_gate, conv_w, w_conv_out, lam_p, subln_g, w_diff_out,
              rel_bias, w_mem_kv, w_mem_out, w_o, lam_init):
    B, S, D = x.shape
    proj = x @ w_in
    c_h, c_b, c_c, dq, dk, dv, mq, gl = jnp.split(proj, IN_SPLITS, axis=-1)

    y = lax.conv_general_dilated(c_c * c_h, conv_w[:, None, :].astype(x.dtype), (1,),
                                 [(CONV_K // 2, CONV_K // 2)],
                                 dimension_numbers=('NWC', 'WIO', 'NWC'),
                                 feature_group_count=CONV_WIDTH)
    out_a = (c_b * y) @ w_conv_out

    lf = lam_p.astype(jnp.float32)
    lam = (jnp.exp(jnp.sum(lf[0] * lf[1])) - jnp.exp(jnp.sum(lf[2] * lf[3])) + lam_init)
    q = dq.reshape(B, S, DIFF_HEADS, 2, DIFF_DK)
    k = dk.reshape(B, S, DIFF_HEADS, 2, DIFF_DK)
    v = dv.reshape(B, S, DIFF_HEADS, DIFF_DV)
    att = diff_attention(q[..., 0, :], q[..., 1, :], k[..., 0, :], k[..., 1, :], v, rel_bias, lam)
    att = rms_norm(att, subln_g) * (1.0 - lam_init)
    out_b = att.reshape(B, S, DIFF_V) @ w_diff_out

    mk, mv = jnp.split(mem @ w_mem_kv, 2, axis=-1)
    mk = mk.reshape(B, -1, MEM_HEADS, MEM_DH)
    mv = mv.reshape(B, -1, MEM_HEADS, MEM_DH)
    mqh = mq.reshape(B, S, MEM_HEADS, MEM_DH) * (MEM_DH ** -0.5)
    s = jnp.einsum('bqhd,bkhd->bhqk', mqh, mk).astype(jnp.float32)
    p = jax.nn.softmax(s, axis=-1)
    o = jnp.einsum('bhqk,bkhd->bqhd', p.astype(mv.dtype), mv).reshape(B, S, MEM_W)
    out_c = o @ w_mem_out

    g = jax.nn.sigmoid((gl + b_gate).astype(jnp.float32)).astype(x.dtype)
    ga, gb, gc = jnp.split(g, N_BRANCH, axis=-1)
    merged = ga * out_a + gb * out_b + gc * out_c
    return merged @ w_o


def setup_inputs(seed: int = 0) -> dict:
    key = jax.random.key(seed)
    ks = jax.random.split(key, 20)
    L, D = DEPTH, D_MODEL
    nrm = lambda k, shp: jax.random.normal(k, shp, dtype=jnp.float32)
    return {
        'x': nrm(ks[0], (BATCH, SEQ, D)),
        'mem': nrm(ks[1], (BATCH, MEM_LEN, D)),
        'w_in': nrm(ks[2], (L, D, N_IN)) * D ** -0.5,
        'b_gate': 0.1 * nrm(ks[3], (L, N_BRANCH * D)),
        'conv_w': nrm(ks[4], (L, CONV_K, CONV_WIDTH)) * CONV_K ** -0.5,
        'w_conv_out': nrm(ks[5], (L, CONV_WIDTH, D)) * CONV_WIDTH ** -0.5,
        'diff_lambda': 0.1 * nrm(ks[6], (L, 4, DIFF_DK)),
        'subln_g': 1.0 + 0.1 * nrm(ks[7], (L, DIFF_DV)),
        'w_diff_out': nrm(ks[8], (L, DIFF_V, D)) * DIFF_V ** -0.5,
        'rel_bias': 0.5 * nrm(ks[9], (REL_BUCKETS, DIFF_HEADS)),
        'w_mem_kv': nrm(ks[10], (L, D, 2 * MEM_W)) * D ** -0.5,
        'w_mem_out': nrm(ks[11], (L, MEM_W, D)) * MEM_W ** -0.5,
        'w_o': nrm(ks[12], (L, D, D)) * (D ** -0.5 * DEEPNORM_BETA),
        'ln1_g': 1.0 + 0.1 * nrm(ks[13], (L, D)),
        'ln1_b': 0.1 * nrm(ks[14], (L, D)),
        'w_mlp1': nrm(ks[15], (L, D, D_FF)) * D ** -0.5,
        'w_mlp2': nrm(ks[16], (L, D_FF, D)) * (D_FF ** -0.5 * DEEPNORM_BETA),
        'ln2_g': 1.0 + 0.1 * nrm(ks[17], (L, D)),
        'ln2_b': 0.1 * nrm(ks[18], (L, D)),
    }


def reference(x, mem, w_in, b_gate, conv_w, w_conv_out, diff_lambda, subln_g, w_diff_out,
              rel_bias, w_mem_kv, w_mem_out, w_o, ln1_g, ln1_b, w_mlp1, w_mlp2, ln2_g, ln2_b):
    for l in range(DEPTH):
        lam_init = 0.8 - 0.6 * math.exp(-0.3 * l)
        h = token_mix(x, mem, w_in[l], b_gate[l], conv_w[l], w_conv_out[l], diff_lambda[l],
                      subln_g[l], w_diff_out[l], rel_bias, w_mem_kv[l], w_mem_out[l], w_o[l],
                      lam_init)
        x = layer_norm(DEEPNORM_ALPHA * x + h, ln1_g[l], ln1_b[l])
        f = jnp.square(jax.nn.relu(x @ w_mlp1[l])) @ w_mlp2[l]
        x = layer_norm(DEEPNORM_ALPHA * x + f, ln2_g[l], ln2_b[l])
    return x
```

```cpp
#include <hip/hip_runtime.h>
#include <hip/hip_cooperative_groups.h>
#include <cstdio>
#include <cstdint>
namespace cg = cooperative_groups;
namespace pg8 {
#define PG8_LAS __attribute__((address_space(3)))
typedef unsigned short bf16_t;
typedef short bf16x8 __attribute__((ext_vector_type(8)));
typedef float f32x4 __attribute__((ext_vector_type(4)));
typedef unsigned u32x4 __attribute__((ext_vector_type(4)));
constexpr int BM = 256, BK = 64, HALF = 128, HTB = HALF * BK * 2  , STAGE_BYTES = 8 * HTB, NXCD = 8, WGM = 8;

__host__ __device__ __forceinline__ int lds_byte(int r, int c) { const int st = (r >> 4) * 2 + (c >> 5), rr = r & 15, cc = c & 31, ob = rr * 64 + cc * 2; return st * 1024 + (ob ^ (((ob >> 9) & 1) << 5)); }
__host__ __device__ __forceinline__ void stage_rc(int b, int& R, int& C) { const int st = b / 1024, sb = b % 1024, swz = sb ^ (((sb >> 9) & 1) << 5); R = (st >> 1) * 16 + swz / 64; C = (st & 1) * 32 + (swz % 64) / 2; }
__host__ __device__ __forceinline__ int perm32(int rho) { const int n = rho >> 4, i = rho & 15; return 8 * (i >> 2) + 4 * n + (i & 3); }

struct Unit { int pm, pn; };
struct Gemm { const bf16_t* A; const bf16_t* Bt; int M, N, K; };

struct StaticOrder {
    int nM, nN, nwg, G, c;
    __host__ __device__ void init(int M, int N, int G_, int c_) { nM = M / BM; nN = N / BM; nwg = nM * nN; G = G_; c = c_; }
    __host__ __device__ bool next(int i, Unit& u) const {
        const long L = (long)i * G + c; if (L >= nwg) return false;
        int wgid = (int)L; { const int q = nwg / NXCD, r = nwg % NXCD, xcd = wgid % NXCD, off = wgid / NXCD; wgid = (xcd < r ? xcd * (q + 1) : r * (q + 1) + (xcd - r) * q) + off; }
        const int nig = WGM * nN, gid = wgid / nig, fm = gid * WGM, gsz = (nM - fm) < WGM ? (nM - fm) : WGM;
        u.pm = fm + ((wgid % nig) % gsz); u.pn = (wgid % nig) / gsz; return true;
    }
    __device__ __forceinline__ void a_ready(const Unit&) const {}
    __device__ __forceinline__ void done(const Unit&) const {}
};


__device__ __forceinline__ unsigned cvt_pk_bf16(float lo, float hi) { unsigned r; asm volatile("v_cvt_pk_bf16_f32 %0, %1, %2" : "=v"(r) : "v"(lo), "v"(hi)); return r; }
__device__ __forceinline__ u32x4 pack8(const f32x4& v0, const f32x4& v1) { u32x4 w; w.x = cvt_pk_bf16(v0[0], v0[1]); w.y = cvt_pk_bf16(v0[2], v0[3]); w.z = cvt_pk_bf16(v1[0], v1[1]); w.w = cvt_pk_bf16(v1[2], v1[3]); return w; }
__device__ __forceinline__ void unpack8(const u32x4& w, f32x4& v0, f32x4& v1) {
    v0[0] = __uint_as_float(w.x << 16); v0[1] = __uint_as_float(w.x & 0xffff0000u); v0[2] = __uint_as_float(w.y << 16); v0[3] = __uint_as_float(w.y & 0xffff0000u);
    v1[0] = __uint_as_float(w.z << 16); v1[1] = __uint_as_float(w.z & 0xffff0000u); v1[2] = __uint_as_float(w.w << 16); v1[3] = __uint_as_float(w.w & 0xffff0000u); }

template <int ACT  > struct EpiBf16 {
    static constexpr bool PERM = true, AFTER_DRAIN = false;
    bf16_t* O; int ldc;
    __device__ __forceinline__ bool operator()(f32x4 (&acc)[2][2][4][2], const Unit& u, int wr, int wc, int fr, int fq) const {
        const int row0 = u.pm * BM + wr * 64 + fr, col0 = u.pn * BM + wc * 32 + 8 * fq;
#pragma unroll
        for (int ai = 0; ai < 2; ++ai)
#pragma unroll
            for (int m = 0; m < 4; ++m) { bf16_t* rowp = O + (size_t)(row0 + ai * HALF + m * 16) * ldc + col0;
#pragma unroll
                for (int bj = 0; bj < 2; ++bj) { f32x4 v0 = acc[ai][bj][m][0], v1 = acc[ai][bj][m][1];
                    if (ACT == 1) {
#pragma unroll
                        for (int e = 0; e < 4; ++e) { const float a = fmaxf(v0[e], 0.f), b = fmaxf(v1[e], 0.f); v0[e] = a * a; v1[e] = b * b; } }
                    *(u32x4*)(rowp + bj * HALF) = pack8(v0, v1); } }
        return true;
    }
};
struct EpiProj {
    static constexpr bool PERM = true, AFTER_DRAIN = false;
    bf16_t* O; int ldc; const float* bgate; float qscale, mqscale;
    __device__ __forceinline__ bool operator()(f32x4 (&acc)[2][2][4][2], const Unit& u, int wr, int wc, int fr, int fq) const {
        const int row0 = u.pm * BM + wr * 64 + fr, col0 = u.pn * BM + wc * 32 + 8 * fq;
        const int kind = (u.pn >= 28) ? 2 : ((u.pn >= 12 && u.pn < 16) ? 1 : ((u.pn >= 24) ? 3 : 0));
        const float sc = kind == 1 ? qscale : (kind == 3 ? mqscale : 1.f);
        f32x4 bv[2][2];
#pragma unroll
        for (int bj = 0; bj < 2; ++bj)
#pragma unroll
            for (int n = 0; n < 2; ++n) bv[bj][n] = (kind == 2) ? *(const f32x4*)(bgate + (col0 - 7168) + bj * HALF + 4 * n) : (f32x4){0.f, 0.f, 0.f, 0.f};
#pragma unroll
        for (int ai = 0; ai < 2; ++ai)
#pragma unroll
            for (int m = 0; m < 4; ++m) { bf16_t* rowp = O + (size_t)(row0 + ai * HALF + m * 16) * ldc + col0;
#pragma unroll
                for (int bj = 0; bj < 2; ++bj) { f32x4 v0 = acc[ai][bj][m][0], v1 = acc[ai][bj][m][1];
                    if (kind == 2) { v0 = v0 + bv[bj][0]; v1 = v1 + bv[bj][1];
#pragma unroll
                        for (int e = 0; e < 4; ++e) { v0[e] = __builtin_amdgcn_rcpf(1.f + __builtin_amdgcn_exp2f(-1.4426950408889634f * v0[e])); v1[e] = __builtin_amdgcn_rcpf(1.f + __builtin_amdgcn_exp2f(-1.4426950408889634f * v1[e])); } }
                    else { v0 = v0 * sc; v1 = v1 * sc; }
                    *(u32x4*)(rowp + bj * HALF) = pack8(v0, v1); } }
        return true;
    }
};
struct EpiResid {
    static constexpr bool PERM = true, AFTER_DRAIN = false;
    const float* base; float* out; int ldc; float alpha;
    __device__ __forceinline__ bool operator()(f32x4 (&acc)[2][2][4][2], const Unit& u, int wr, int wc, int fr, int fq) const {
        const int row0 = u.pm * BM + wr * 64 + fr, col0 = u.pn * BM + wc * 32 + 8 * fq;
#pragma unroll
        for (int ai = 0; ai < 2; ++ai)
#pragma unroll
            for (int m = 0; m < 4; ++m) { const size_t off = (size_t)(row0 + ai * HALF + m * 16) * ldc + col0;
#pragma unroll
                for (int bj = 0; bj < 2; ++bj) {
                    const f32x4 b0 = *(const f32x4*)(base + off + bj * HALF), b1 = *(const f32x4*)(base + off + bj * HALF + 4);
                    *(f32x4*)(out + off + bj * HALF) = b0 * alpha + acc[ai][bj][m][0]; *(f32x4*)(out + off + bj * HALF + 4) = b1 * alpha + acc[ai][bj][m][1]; } }
        return true;
    }
};
struct EpiMerge {
    static constexpr bool PERM = true, AFTER_DRAIN = false;
    const bf16_t* gates; int ldg; bf16_t* O; int ldc;
    __device__ __forceinline__ bool operator()(f32x4 (&acc)[2][2][4][2], const Unit& u, int wr, int wc, int fr, int fq) const {
        const int br = u.pm >> 6, pm = u.pm & 63, pn = u.pn & 3;
        const int row0 = pm * BM + wr * 64 + fr, col0 = pn * BM + wc * 32 + 8 * fq;
        const float tiny = 1e-30f;
#pragma unroll
        for (int ai = 0; ai < 2; ++ai)
#pragma unroll
            for (int m = 0; m < 4; ++m) { const int row = row0 + ai * HALF + m * 16;
#pragma unroll
                for (int bj = 0; bj < 2; ++bj) { const int col = col0 + bj * HALF;
                    f32x4 g0, g1; unpack8(*(const u32x4*)(gates + (size_t)row * ldg + br * 1024 + col), g0, g1);
#pragma unroll
                    for (int e = 0; e < 4; ++e) { g0[e] = fmaxf(g0[e], tiny); g1[e] = fmaxf(g1[e], tiny); }
                    if (br < 2) { f32x4 h0, h1; unpack8(*(const u32x4*)(gates + (size_t)row * ldg + (br + 1) * 1024 + col), h0, h1);
#pragma unroll
                        for (int e = 0; e < 4; ++e) { g0[e] = g0[e] * __builtin_amdgcn_rcpf(fmaxf(h0[e], tiny)); g1[e] = g1[e] * __builtin_amdgcn_rcpf(fmaxf(h1[e], tiny)); } }
                    acc[ai][bj][m][0] = acc[ai][bj][m][0] * g0; acc[ai][bj][m][1] = acc[ai][bj][m][1] * g1;
                    if (br == 2) *(u32x4*)(O + (size_t)row * ldc + col) = pack8(acc[ai][bj][m][0], acc[ai][bj][m][1]); } }
        return br == 2;
    }
};
struct MergeOrder {
    StaticOrder base;
    __host__ __device__ void init(int M, int N, int G_, int c_) { base.init(M, N, G_, c_); }
    __host__ __device__ bool next(int i, Unit& u) const { const int j = i / 3, br = i - 3 * j; Unit t; if (!base.next(j, t)) return false; u.pm = t.pm + 64 * br; u.pn = t.pn + 4 * br; return true; }
    __device__ __forceinline__ void a_ready(const Unit&) const {}
    __device__ __forceinline__ void done(const Unit&) const {}
};
template <class Epi, class Sched, bool ALIGN_EPI = false, bool SP2 = false>
__device__ __forceinline__ void gemm_phase(PG8_LAS unsigned char* lds, const Gemm g, const Sched& S, const Epi& E) {
    int tid = threadIdx.x; asm volatile("" : "+v"(tid));
    const int wid = __builtin_amdgcn_readfirstlane(tid >> 6), lane = tid & 63, wr = wid >> 2, wc = wid & 3, fr = lane & 15, fq = lane >> 4;
    const int K = g.K, nt = K / BK;
    unsigned voffA[2], voffB[2];
#pragma unroll
    for (int i = 0; i < 2; ++i) { int R, C; stage_rc(tid * 16 + i * 8192, R, C); const int Rb = Epi::PERM ? ((R & ~31) + perm32(R & 31)) : R;
        voffA[i] = (unsigned)(R * K + C) * 2u; voffB[i] = (unsigned)(Rb * K + C) * 2u; }
    const size_t kstep = (size_t)(BK * 2);
    const size_t hstep = (size_t)HALF * K * 2;
    const size_t tstep = 2 * hstep;
    const unsigned ldsw = (unsigned)wid * 1024u;
    const int aoff = lds_byte(wr * 64 + fr, fq * 8), boff = lds_byte(wc * 32 + fr, fq * 8);
#define PG8_SA(b, h) (((b) * 2 + (h)) * HTB)
#define PG8_SB(b, h) ((4 + (b) * 2 + (h)) * HTB)
#define PG8_STAGE(bufoff, gbase, voff) do { _Pragma("unroll") for (int _i = 0; _i < 2; ++_i) \
        __builtin_amdgcn_global_load_lds((const unsigned*)((const char*)(gbase) + (voff)[_i]), (PG8_LAS unsigned*)(lds + (bufoff) + ldsw + _i * 8192), 16, 0, 0); } while (0)
#define PG8_LDA(dst, b, h) do { _Pragma("unroll") for (int m = 0; m < 4; ++m) _Pragma("unroll") for (int k = 0; k < 2; ++k) dst[m][k] = *(const PG8_LAS bf16x8*)(lds + PG8_SA(b, h) + aoff + m * 2048 + k * 1024); } while (0)
#define PG8_LDB(dst, b, h) do { _Pragma("unroll") for (int n = 0; n < 2; ++n) _Pragma("unroll") for (int k = 0; k < 2; ++k) dst[n][k] = *(const PG8_LAS bf16x8*)(lds + PG8_SB(b, h) + boff + n * 2048 + k * 1024); } while (0)
#define PG8_MMA(ai, bj, At, Bt) do { __builtin_amdgcn_s_setprio(1); _Pragma("unroll") for (int m = 0; m < 4; ++m) _Pragma("unroll") for (int n = 0; n < 2; ++n) _Pragma("unroll") for (int k = 0; k < 2; ++k) \
        acc[ai][bj][m][n] = __builtin_amdgcn_mfma_f32_16x16x32_bf16(Bt[n][k], At[m][k], acc[ai][bj][m][n], 0, 0, 0); __builtin_amdgcn_s_setprio(0); } while (0)
#define PG8_WAIT_V(n) asm volatile("s_waitcnt vmcnt(" #n ")" ::: "memory")
#define PG8_WAIT_L(n) asm volatile("s_waitcnt lgkmcnt(" #n ")" ::: "memory")
#define PG8_BAR __builtin_amdgcn_s_barrier()
#define PG8_SCHED __builtin_amdgcn_sched_barrier(0)
    Unit cur, nxt; int ui = 0;
    if (!S.next(0, cur)) return;
    f32x4 acc[2][2][4][2];
#pragma unroll
    for (int a = 0; a < 2; ++a)
#pragma unroll
        for (int b = 0; b < 2; ++b)
#pragma unroll
            for (int m = 0; m < 4; ++m)
#pragma unroll
                for (int n = 0; n < 2; ++n) acc[a][b][m][n] = (f32x4){0.f, 0.f, 0.f, 0.f};
    bf16x8 At[4][2], B0[2][2], B1[2][2];
    const char* cA = (const char*)g.A + (size_t)cur.pm * tstep; const char* cB = (const char*)g.Bt + (size_t)cur.pn * tstep;
    S.a_ready(cur);
    if constexpr (SP2) {
        PG8_STAGE(PG8_SB(0, 0), cB, voffB); PG8_STAGE(PG8_SB(0, 1), cB + hstep, voffB); PG8_STAGE(PG8_SA(0, 0), cA, voffA); PG8_STAGE(PG8_SA(0, 1), cA + hstep, voffA);
        if (wr == 1) PG8_BAR;
        PG8_WAIT_V(2); PG8_BAR;
        PG8_STAGE(PG8_SB(1, 0), cB + kstep, voffB); PG8_STAGE(PG8_SA(1, 0), cA + kstep, voffA); PG8_STAGE(PG8_SB(1, 1), cB + hstep + kstep, voffB);
        PG8_WAIT_V(6); PG8_BAR;
    } else {
        PG8_STAGE(PG8_SB(0, 0), cB, voffB); PG8_STAGE(PG8_SA(0, 0), cA, voffA); PG8_STAGE(PG8_SB(0, 1), cB + hstep, voffB); PG8_STAGE(PG8_SA(0, 1), cA + hstep, voffA);
        if (wr == 1) PG8_BAR;
        PG8_WAIT_V(4); PG8_BAR;
        PG8_STAGE(PG8_SB(1, 0), cB + kstep, voffB); PG8_STAGE(PG8_SA(1, 0), cA + kstep, voffA); PG8_STAGE(PG8_SB(1, 1), cB + hstep + kstep, voffB);
        PG8_WAIT_V(6); PG8_BAR;
    }
    for (;;) {
        const bool has_next = S.next(ui + 1, nxt);
        const char* nA = has_next ? (const char*)g.A + (size_t)nxt.pm * tstep : cA; const char* nB = has_next ? (const char*)g.Bt + (size_t)nxt.pn * tstep : cB;
        for (int t = 0; t < nt; t += 2) {
            const bool last = (t == nt - 2);
            const char* a1 = cA + (size_t)(t + 1) * kstep;
            const char* a2 = last ? nA : cA + (size_t)(t + 2) * kstep; const char* b2 = last ? nB : cB + (size_t)(t + 2) * kstep;
            const char* a3 = a2 + kstep; const char* b3 = b2 + kstep;
            if (last && has_next) S.a_ready(nxt);
            if constexpr (SP2) {
            PG8_LDB(B0, 0, 0); PG8_LDB(B1, 0, 1); PG8_SCHED; PG8_LDA(At, 0, 0); PG8_STAGE(PG8_SA(1, 1), a1 + hstep, voffA);
            PG8_WAIT_V(8); PG8_WAIT_L(0); PG8_BAR; PG8_MMA(0, 0, At, B0); PG8_MMA(0, 1, At, B1); PG8_BAR; PG8_SCHED;
            PG8_LDA(At, 0, 1); PG8_STAGE(PG8_SB(0, 0), b2, voffB); PG8_STAGE(PG8_SB(0, 1), b2 + hstep, voffB); PG8_STAGE(PG8_SA(0, 0), a2, voffA);
            PG8_WAIT_V(8); PG8_WAIT_L(0); PG8_BAR; PG8_MMA(1, 0, At, B0); PG8_MMA(1, 1, At, B1); PG8_BAR; PG8_SCHED;
            PG8_LDB(B0, 1, 0); PG8_LDB(B1, 1, 1); PG8_SCHED; PG8_LDA(At, 1, 0); PG8_STAGE(PG8_SA(0, 1), a2 + hstep, voffA);
            PG8_WAIT_V(8); PG8_WAIT_L(0); PG8_BAR; PG8_MMA(0, 0, At, B0); PG8_MMA(0, 1, At, B1); PG8_BAR; PG8_SCHED;
            PG8_LDA(At, 1, 1); PG8_STAGE(PG8_SB(1, 0), b3, voffB); PG8_STAGE(PG8_SB(1, 1), b3 + hstep, voffB); PG8_STAGE(PG8_SA(1, 0), a3, voffA);
            PG8_WAIT_V(8); PG8_WAIT_L(0); PG8_BAR; PG8_MMA(1, 0, At, B0); PG8_MMA(1, 1, At, B1); PG8_BAR; PG8_SCHED;
            } else {
            PG8_LDB(B0, 0, 0); PG8_SCHED; PG8_LDA(At, 0, 0); PG8_STAGE(PG8_SA(1, 1), a1 + hstep, voffA);
            PG8_WAIT_L(8); PG8_BAR; PG8_WAIT_L(0); PG8_MMA(0, 0, At, B0); PG8_BAR; PG8_SCHED;
            PG8_LDB(B1, 0, 1); PG8_STAGE(PG8_SB(0, 0), b2, voffB);
            PG8_BAR; PG8_WAIT_L(0); PG8_MMA(0, 1, At, B1); PG8_BAR;
            PG8_LDA(At, 0, 1); PG8_STAGE(PG8_SA(0, 0), a2, voffA);
            PG8_BAR; PG8_WAIT_L(0); PG8_MMA(1, 0, At, B0); PG8_BAR; PG8_SCHED;
            PG8_STAGE(PG8_SB(0, 1), b2 + hstep, voffB);
            PG8_WAIT_V(6); PG8_BAR; PG8_MMA(1, 1, At, B1); PG8_BAR;
            PG8_LDB(B0, 1, 0); PG8_SCHED; PG8_LDA(At, 1, 0); PG8_STAGE(PG8_SA(0, 1), a2 + hstep, voffA);
            PG8_WAIT_L(8); PG8_BAR; PG8_WAIT_L(0); PG8_MMA(0, 0, At, B0); PG8_BAR; PG8_SCHED;
            PG8_LDB(B1, 1, 1); PG8_STAGE(PG8_SB(1, 0), b3, voffB);
            PG8_BAR; PG8_WAIT_L(0); PG8_MMA(0, 1, At, B1); PG8_BAR;
            PG8_LDA(At, 1, 1); PG8_STAGE(PG8_SA(1, 0), a3, voffA);
            PG8_BAR; PG8_WAIT_L(0); PG8_MMA(1, 0, At, B0); PG8_BAR; PG8_SCHED;
            PG8_STAGE(PG8_SB(1, 1), b3 + hstep, voffB);
            PG8_WAIT_V(6); PG8_BAR; PG8_MMA(1, 1, At, B1); PG8_BAR;
            }
        }
        if constexpr (ALIGN_EPI) { if (wr == 0) PG8_BAR; }
        bool reset_ = true; if constexpr (!Epi::AFTER_DRAIN) { reset_ = E(acc, cur, wr, wc, fr, fq); S.done(cur); }
        if (!has_next) break;
        if (reset_)
#pragma unroll
        for (int a = 0; a < 2; ++a)
#pragma unroll
            for (int b = 0; b < 2; ++b)
#pragma unroll
                for (int m = 0; m < 4; ++m)
#pragma unroll
                    for (int n = 0; n < 2; ++n) acc[a][b][m][n] = (f32x4){0.f, 0.f, 0.f, 0.f};
        cur = nxt; cA = nA; cB = nB; ++ui;
        if constexpr (ALIGN_EPI) { if (wr == 1) PG8_BAR; }
    }
    PG8_WAIT_V(0);
    if constexpr (!ALIGN_EPI) { if (wr == 0) PG8_BAR; }
    PG8_BAR;
    if constexpr (Epi::AFTER_DRAIN) { E.fused(acc, cur, wr, wc, fr, fq, lds, wid, lane); S.done(cur); }
#undef PG8_SA
#undef PG8_SB
#undef PG8_STAGE
#undef PG8_LDA
#undef PG8_LDB
#undef PG8_MMA
#undef PG8_WAIT_V
#undef PG8_WAIT_L
#undef PG8_BAR
#undef PG8_SCHED
}
}

constexpr int D_MODEL = 1024, BATCH = 8, SEQ = 2048, DEPTH = 4, MEM_LEN = 256, NIN = 10240, D_FF = 4096;
constexpr int M_TOK = BATCH * SEQ;
constexpr int COL_CH = 0, COL_CB = 1024, COL_CC = 2048, COL_DQ = 3072, COL_DK = 4096, COL_DV = 5120, COL_MQ = 6144, COL_GL = 7168;
constexpr float LN_EPS = 1e-5f, LOG2E = 1.4426950408889634f;
constexpr float DN_ALPHA = 1.681792830507429f;
constexpr int MKV_LD = DEPTH * 2048;

namespace att {
using bf16 = unsigned short;
using bf16x8 = __attribute__((ext_vector_type(8))) short;
using s16x4  = __attribute__((ext_vector_type(4))) short;
using f32x16 = __attribute__((ext_vector_type(16))) float;
using u32x4  = __attribute__((ext_vector_type(4))) unsigned;
constexpr int KVBLK = 64;
constexpr int SHM_T = 16384;
constexpr int LDS_WS = 65536, LDS_TBL = 65536 + 2048, LDS_MISC = 65536 + 2048 + 1280;
#define KSWZ(row, colB) ((row) * 256 + ((colB) ^ (((row) & 7) << 4)))
#define SBAR() __builtin_amdgcn_sched_barrier(0)
constexpr float THR = 8.f;
__device__ __forceinline__ int crow(int r, int hi) { return (r & 3) + 8 * (r >> 2) + 4 * hi; }
__device__ __forceinline__ unsigned cvtpk(float lo, float hi) { unsigned r; asm volatile("v_cvt_pk_bf16_f32 %0, %1, %2" : "=v"(r) : "v"(lo), "v"(hi)); return r; }
__device__ __forceinline__ bf16x8 ld8(const bf16* p) { return *reinterpret_cast<const bf16x8*>(p); }

__device__ __forceinline__ int t5_bucket(int rel) {
  const int n = rel < 0 ? -rel : rel; int v;
  if (n < 8) v = n; else if (n < 12) v = 8; else if (n < 16) v = 9; else if (n < 23) v = 10; else if (n < 32) v = 11; else if (n < 46) v = 12; else if (n < 64) v = 13; else if (n < 91) v = 14; else v = 15;
  return (rel > 0 ? 16 : 0) + v;
}
__device__ __forceinline__ void add_bias(f32x16& p0, f32x16& p1, int key0, int qw0, int r32, int hi, const float* tbl) {
  const int dmin = key0 - qw0 - 31, dmax = key0 + 63 - qw0;
  if (dmin >= 128) { const float c = tbl[256];
#pragma unroll
    for (int r = 0; r < 16; ++r) { p0[r] += c; p1[r] += c; } }
  else if (dmax <= -128) { const float c = tbl[0];
#pragma unroll
    for (int r = 0; r < 16; ++r) { p0[r] += c; p1[r] += c; } }
  else { const int base = key0 - qw0 - r32 + 128 + 4 * hi;
#pragma unroll
    for (int r = 0; r < 16; ++r) { const int d = base + (r & 3) + 8 * (r >> 2); const int i0 = min(max(d, 0), 256), i1 = min(max(d + 32, 0), 256); p0[r] += tbl[i0]; p1[r] += tbl[i1]; } }
}
__device__ __forceinline__ void partialSM(f32x16& p0, f32x16& p1, float& m_reg, float& mn, float& alpha) {
  float pmax = p0[0];
#pragma unroll
  for (int r = 1; r < 16; ++r) pmax = fmaxf(pmax, p0[r]);
#pragma unroll
  for (int r = 0; r < 16; ++r) pmax = fmaxf(pmax, p1[r]);
  { auto rr = __builtin_amdgcn_permlane32_swap(__float_as_uint(pmax), __float_as_uint(pmax), false, false);
    pmax = fmaxf(__uint_as_float(rr[0]), __uint_as_float(rr[1])); }
  if (__builtin_expect(__all(pmax - m_reg <= THR), 1)) { mn = m_reg; alpha = 1.f; }
  else { mn = fmaxf(m_reg, pmax); alpha = __builtin_amdgcn_exp2f(m_reg - mn); m_reg = mn; }
#pragma unroll
  for (int r = 0; r < 16; ++r) { p0[r] -= mn; p1[r] -= mn; }
#pragma unroll
  for (int r = 0; r < 16; ++r) p0[r] = __builtin_amdgcn_exp2f(p0[r]);
}
#define PK4(P, BASE, OUT) do { unsigned a0 = cvtpk(P[BASE + 0], P[BASE + 1]), a1 = cvtpk(P[BASE + 2], P[BASE + 3]);   \
    unsigned b0 = cvtpk(P[BASE + 4], P[BASE + 5]), b1 = cvtpk(P[BASE + 6], P[BASE + 7]);                              \
    auto r0 = __builtin_amdgcn_permlane32_swap(a0, b0, false, false); auto r1 = __builtin_amdgcn_permlane32_swap(a1, b1, false, false); \
    u32x4 w = {r0[0], r1[0], r0[1], r1[1]}; OUT = *reinterpret_cast<bf16x8*>(&w); } while (0)
__device__ __forceinline__ void finishSM(f32x16& p0, f32x16& p1, float alpha, float& l_reg, bf16x8& pa0, bf16x8& pa1, bf16x8& pa2, bf16x8& pa3) {
#pragma unroll
  for (int r = 0; r < 16; ++r) p1[r] = __builtin_amdgcn_exp2f(p1[r]);
  float ps = 0;
#pragma unroll
  for (int r = 0; r < 16; ++r) ps += p0[r];
#pragma unroll
  for (int r = 0; r < 16; ++r) ps += p1[r];
  { auto rr = __builtin_amdgcn_permlane32_swap(__float_as_uint(ps), __float_as_uint(ps), false, false);
    ps = __uint_as_float(rr[0]) + __uint_as_float(rr[1]); }
  l_reg = l_reg * alpha + ps;
  PK4(p0, 0, pa0); PK4(p0, 8, pa1); PK4(p1, 0, pa2); PK4(p1, 8, pa3);
}
template <int NS, bool ZERO> __device__ __forceinline__ void qkt(f32x16& p0, f32x16& p1, const char* Ks, const bf16x8* qr, int cb0, int r32, int hi) {
  if (ZERO) { p0 = f32x16{}; p1 = f32x16{}; }
#pragma unroll
  for (int d0 = 0; d0 < NS; ++d0) { const int cb = cb0 + (d0 * 16 + hi * 8) * 2;
    bf16x8 b0 = *reinterpret_cast<const bf16x8*>(Ks + KSWZ(r32, cb));
    bf16x8 b1 = *reinterpret_cast<const bf16x8*>(Ks + KSWZ(32 + r32, cb));
    p0 = __builtin_amdgcn_mfma_f32_32x32x16_bf16(b0, qr[d0], p0, 0, 0, 0);
    p1 = __builtin_amdgcn_mfma_f32_32x32x16_bf16(b1, qr[d0], p1, 0, 0, 0); }
}
__device__ __forceinline__ int v_st(int k, int c) { const int kk = (k & ~0xC) | ((k & 4) << 1) | ((k & 8) >> 1); return ((kk >> 3) * 4 + (c >> 5)) * 512 + ((kk & 7) * 32 + (c & 31)) * 2; }
__device__ __forceinline__ int v_rd_base(int lane) { return ((lane & 3) << 3) | (((lane >> 2) & 3) << 6) | (((lane >> 4) & 1) << 5) | (((lane >> 5) & 1) << 8); }
constexpr int v_rd_off(int d0, int ks, int half) { return d0 * 512 + ks * 4096 + half * 2048; }
template <int OFF> __device__ __forceinline__ s16x4 tr_read(int vb) {
  s16x4 r; asm volatile("ds_read_b64_tr_b16 %0, %1 offset:%2" : "=&v"(r) : "v"(vb), "i"(OFF) : "memory"); return r;
}
template <int D0> __device__ __forceinline__ void pv_one(f32x16& od, int vb, bf16x8 pa0, bf16x8 pa1, bf16x8 pa2, bf16x8 pa3) {
  const s16x4 l0 = tr_read<v_rd_off(D0, 0, 0)>(vb), h0 = tr_read<v_rd_off(D0, 0, 1)>(vb), l1 = tr_read<v_rd_off(D0, 1, 0)>(vb), h1 = tr_read<v_rd_off(D0, 1, 1)>(vb);
  const s16x4 l2 = tr_read<v_rd_off(D0, 2, 0)>(vb), h2 = tr_read<v_rd_off(D0, 2, 1)>(vb), l3 = tr_read<v_rd_off(D0, 3, 0)>(vb), h3 = tr_read<v_rd_off(D0, 3, 1)>(vb);
  asm volatile("s_waitcnt lgkmcnt(0)" ::: "memory"); SBAR();
#define PKV(L, H) (bf16x8){L[0], L[1], L[2], L[3], H[0], H[1], H[2], H[3]}
  od = __builtin_amdgcn_mfma_f32_32x32x16_bf16(pa0, PKV(l0, h0), od, 0, 0, 0);
  od = __builtin_amdgcn_mfma_f32_32x32x16_bf16(pa1, PKV(l1, h1), od, 0, 0, 0);
  od = __builtin_amdgcn_mfma_f32_32x32x16_bf16(pa2, PKV(l2, h2), od, 0, 0, 0);
  od = __builtin_amdgcn_mfma_f32_32x32x16_bf16(pa3, PKV(l3, h3), od, 0, 0, 0);
#undef PKV
}
__device__ __forceinline__ void pv_d0(f32x16* o, int vb, bf16x8 pa0, bf16x8 pa1, bf16x8 pa2, bf16x8 pa3) {
  pv_one<0>(o[0], vb, pa0, pa1, pa2, pa3); pv_one<1>(o[1], vb, pa0, pa1, pa2, pa3); pv_one<2>(o[2], vb, pa0, pa1, pa2, pa3); pv_one<3>(o[3], vb, pa0, pa1, pa2, pa3);
}

__device__ __forceinline__ void diff_unit(const bf16* __restrict__ proj, bf16* __restrict__ att_out, int b, int h, int qb, float lam, float post,
                                          const float* __restrict__ subln_g, const float* __restrict__ rel_bias, char* lds) {
  int tid = threadIdx.x; asm volatile("" : "+v"(tid));
  const int wid = __builtin_amdgcn_readfirstlane(tid >> 6), lane = tid & 63, r32 = lane & 31, hi = lane >> 5, map = wid >> 2, wq = wid & 3;
  char* V_lds = lds; char* K_lds = lds + 2 * SHM_T;
  float* ws = (float*)(lds + LDS_WS) + wid * 64; float* li_l = ws; float* al_l = ws + 32;
  float* tbl = (float*)(lds + LDS_TBL);
  if (tid < 257) tbl[tid] = rel_bias[t5_bucket(tid - 128) * 8 + h] * LOG2E;
  const long tok0 = (long)b * SEQ;
  const bf16* Qw = proj + (tok0 + qb * 128 + wq * 32 + r32) * NIN + COL_DQ + h * 128 + map * 64 + hi * 8;
  const bf16* Kh = proj + tok0 * NIN + COL_DK + h * 128;
  const bf16* Vh = proj + tok0 * NIN + COL_DV + h * 128;
  float m_reg = -1e30f, l_reg = 0; f32x16 o[4] = {}; bf16x8 qr[4];
#pragma unroll
  for (int d0 = 0; d0 < 4; ++d0) qr[d0] = ld8(Qw + d0 * 16);
  const int sr = tid >> 4, sc = (tid & 15) * 8, vst0 = v_st(sr, sc), vst1 = v_st(32 + sr, sc);
  const int vb0 = (int)(uintptr_t)V_lds + v_rd_base(lane);
  const int qw0 = qb * 128 + wq * 32, cbm = map * 128;
  struct { bf16x8 vs0, vs1, ks0, ks1; } sr_[2];
#define SLOAD(i, k0) do { sr_[i].vs0 = ld8(&Vh[(long)((k0) + sr) * NIN + sc]); sr_[i].vs1 = ld8(&Vh[(long)((k0) + 32 + sr) * NIN + sc]); \
    sr_[i].ks0 = ld8(&Kh[(long)((k0) + sr) * NIN + sc]); sr_[i].ks1 = ld8(&Kh[(long)((k0) + 32 + sr) * NIN + sc]); } while (0)
#define SWRITE(bb, i) do { *(bf16x8*)(V_lds + (bb) * SHM_T + vst0) = sr_[i].vs0;          \
    *(bf16x8*)(V_lds + (bb) * SHM_T + vst1) = sr_[i].vs1; const int kc = sc * 2;               \
    *(bf16x8*)(K_lds + (bb) * SHM_T + KSWZ(sr, kc)) = sr_[i].ks0;                       \
    *(bf16x8*)(K_lds + (bb) * SHM_T + KSWZ(32 + sr, kc)) = sr_[i].ks1; } while (0)
#define SWAIT() asm volatile("s_waitcnt vmcnt(4)" ::: "memory")
#define RESC(a) do { if (__any((a) < 1.f)) { if (hi == 0) al_l[r32] = (a); asm volatile("s_waitcnt lgkmcnt(0)" ::: "memory"); \
    _Pragma("unroll") for (int d = 0; d < 4; ++d) _Pragma("unroll") for (int r = 0; r < 16; ++r) o[d][r] *= al_l[crow(r, hi)]; } } while (0)
  f32x16 pA0, pA1, pB0, pB1; float mnA, mnB, alA, alB; bf16x8 pa0, pa1, pa2, pa3; constexpr int NT = SEQ / KVBLK;
  SLOAD(0, 0); asm volatile("s_waitcnt vmcnt(0)" ::: "memory"); SWRITE(0, 0); __syncthreads();
  qkt<4, true>(pA0, pA1, K_lds, qr, cbm, r32, hi); add_bias(pA0, pA1, 0, qw0, r32, hi, tbl); partialSM(pA0, pA1, m_reg, mnA, alA);
  SLOAD(1, KVBLK); SLOAD(0, 2 * KVBLK);
  SWAIT(); SWRITE(1, 1); __syncthreads();
  for (int j = 1; j + 1 < NT; j += 2) {
    SBAR(); qkt<4, true>(pB0, pB1, K_lds + SHM_T, qr, cbm, r32, hi);
    finishSM(pA0, pA1, alA, l_reg, pa0, pa1, pa2, pa3); SBAR();
    SLOAD(1, (j + 2) * KVBLK); SBAR();
    pv_d0(o, vb0, pa0, pa1, pa2, pa3); add_bias(pB0, pB1, j * KVBLK, qw0, r32, hi, tbl); partialSM(pB0, pB1, m_reg, mnB, alB);
    __syncthreads(); SWAIT(); SWRITE(0, 0);
    RESC(alB); __syncthreads();
    SBAR(); qkt<4, true>(pA0, pA1, K_lds, qr, cbm, r32, hi);
    finishSM(pB0, pB1, alB, l_reg, pa0, pa1, pa2, pa3); SBAR();
    if (j + 3 < NT) SLOAD(0, (j + 3) * KVBLK); SBAR();
    pv_d0(o, vb0 + SHM_T, pa0, pa1, pa2, pa3); add_bias(pA0, pA1, (j + 1) * KVBLK, qw0, r32, hi, tbl); partialSM(pA0, pA1, m_reg, mnA, alA);
    __syncthreads(); SWAIT(); SWRITE(1, 1);
    RESC(alA); __syncthreads();
  }
  SBAR(); qkt<4, true>(pB0, pB1, K_lds + SHM_T, qr, cbm, r32, hi);
  finishSM(pA0, pA1, alA, l_reg, pa0, pa1, pa2, pa3); SBAR();
  pv_d0(o, vb0, pa0, pa1, pa2, pa3); add_bias(pB0, pB1, (NT - 1) * KVBLK, qw0, r32, hi, tbl); partialSM(pB0, pB1, m_reg, mnB, alB);
  __syncthreads(); RESC(alB);
  finishSM(pB0, pB1, alB, l_reg, pa0, pa1, pa2, pa3); SBAR();
  pv_d0(o, vb0 + SHM_T, pa0, pa1, pa2, pa3);
  if (hi == 0) li_l[r32] = l_reg; asm volatile("s_waitcnt lgkmcnt(0)" ::: "memory");
  float rli[16];
#pragma unroll
  for (int r = 0; r < 16; ++r) rli[r] = __builtin_amdgcn_rcpf(li_l[crow(r, hi)]);
#pragma unroll
  for (int d0 = 0; d0 < 4; ++d0)
#pragma unroll
    for (int r = 0; r < 16; ++r) o[d0][r] *= rli[r];
  __syncthreads();
  float* X = (float*)lds;
  if (map == 1) {
#pragma unroll
    for (int d0 = 0; d0 < 4; ++d0)
#pragma unroll
      for (int r = 0; r < 16; ++r) X[((wq * 4 + d0) * 16 + r) * 64 + lane] = o[d0][r];
  }
  __syncthreads();
  if (map == 0) {
    float rs[16];
#pragma unroll
    for (int r = 0; r < 16; ++r) { float ss = 0.f;
#pragma unroll
      for (int d0 = 0; d0 < 4; ++d0) { o[d0][r] -= lam * X[((wq * 4 + d0) * 16 + r) * 64 + lane]; ss += o[d0][r] * o[d0][r]; }
      ss += __shfl_xor(ss, 1); ss += __shfl_xor(ss, 2); ss += __shfl_xor(ss, 4); ss += __shfl_xor(ss, 8); ss += __shfl_xor(ss, 16);
      rs[r] = post / sqrtf(ss * (1.f / 128.f) + LN_EPS); }
    bf16* Ow = att_out + (tok0 + qb * 128 + wq * 32) * D_MODEL + h * 128 + r32;
#pragma unroll
    for (int d0 = 0; d0 < 4; ++d0) { const float g = subln_g[d0 * 32 + r32];
#pragma unroll
      for (int r = 0; r < 16; ++r) Ow[(long)crow(r, hi) * D_MODEL + d0 * 32] = (bf16)(cvtpk(o[d0][r] * rs[r] * g, 0.f) & 0xffffu); }
  }
  __syncthreads();
#undef SLOAD
#undef SWRITE
#undef SWAIT
#undef RESC
}

__device__ __forceinline__ void mem_unit(const bf16* __restrict__ proj, const bf16* __restrict__ mkv, bf16* __restrict__ memo, int b, int h, int qb, char* lds) {
  int tid = threadIdx.x; asm volatile("" : "+v"(tid));
  const int wid = __builtin_amdgcn_readfirstlane(tid >> 6), lane = tid & 63, r32 = lane & 31, hi = lane >> 5;
  float* ws = (float*)(lds + LDS_WS) + wid * 64; float* li_l = ws;
  const long tok0 = (long)b * SEQ;
  const bf16* Qw = proj + (tok0 + qb * 256 + wid * 32 + r32) * NIN + COL_MQ + h * 256 + hi * 8;
  const bf16* Kb = mkv + (long)(b * MEM_LEN) * MKV_LD + h * 256;
  const bf16* Vb = Kb + 1024;
  const int sr = tid >> 4, sc = (tid & 15) * 8, vst0 = v_st(sr, sc), vst1 = v_st(32 + sr, sc), kst0 = KSWZ(sr, sc * 2), kst1 = KSWZ(32 + sr, sc * 2);
  const int vb0 = (int)(uintptr_t)lds + v_rd_base(lane);
  f32x16 s[4][2]; bf16x8 qr[8]; bf16x8 g0, g1;
#define MLOAD(st) do { const bf16* src_ = ((st) < 8 ? Kb : Vb) + (long)(((st) & 3) * 64 + sr) * MKV_LD + (((st) >> 2) & 1) * 128 + sc; g0 = ld8(src_); g1 = ld8(src_ + 32L * MKV_LD); } while (0)
#define MWRITE(st) do { char* dst_ = lds + ((st) & 1) * SHM_T; if ((st) < 8) { *(bf16x8*)(dst_ + kst0) = g0; *(bf16x8*)(dst_ + kst1) = g1; } else { *(bf16x8*)(dst_ + vst0) = g0; *(bf16x8*)(dst_ + vst1) = g1; } } while (0)
  MLOAD(0); MWRITE(0); __syncthreads();
#pragma unroll
  for (int st = 0; st < 8; ++st) {
    MLOAD(st + 1);
    if ((st & 3) == 0) {
#pragma unroll
      for (int d0 = 0; d0 < 8; ++d0) qr[d0] = ld8(Qw + (st >> 2) * 128 + d0 * 16); }
    if (st < 4) qkt<8, true>(s[st & 3][0], s[st & 3][1], lds + (st & 1) * SHM_T, qr, 0, r32, hi);
    else        qkt<8, false>(s[st & 3][0], s[st & 3][1], lds + (st & 1) * SHM_T, qr, 0, r32, hi);
    MWRITE(st + 1); __syncthreads();
  }
  float mx = s[0][0][0];
#pragma unroll
  for (int kt = 0; kt < 4; ++kt)
#pragma unroll
    for (int j = 0; j < 2; ++j)
#pragma unroll
      for (int r = 0; r < 16; ++r) mx = fmaxf(mx, s[kt][j][r]);
  { auto rr = __builtin_amdgcn_permlane32_swap(__float_as_uint(mx), __float_as_uint(mx), false, false); mx = fmaxf(__uint_as_float(rr[0]), __uint_as_float(rr[1])); }
  float ps = 0.f;
#pragma unroll
  for (int kt = 0; kt < 4; ++kt)
#pragma unroll
    for (int j = 0; j < 2; ++j)
#pragma unroll
      for (int r = 0; r < 16; ++r) { const float e = __builtin_amdgcn_exp2f(s[kt][j][r] - mx); s[kt][j][r] = e; ps += e; }
  { auto rr = __builtin_amdgcn_permlane32_swap(__float_as_uint(ps), __float_as_uint(ps), false, false); ps = __uint_as_float(rr[0]) + __uint_as_float(rr[1]); }
  if (hi == 0) li_l[r32] = ps; asm volatile("s_waitcnt lgkmcnt(0)" ::: "memory");
  float rli[16];
#pragma unroll
  for (int r = 0; r < 16; ++r) rli[r] = __builtin_amdgcn_rcpf(li_l[crow(r, hi)]);
  bf16x8 pa[4][4];
#pragma unroll
  for (int kt = 0; kt < 4; ++kt) { PK4(s[kt][0], 0, pa[kt][0]); PK4(s[kt][0], 8, pa[kt][1]); PK4(s[kt][1], 0, pa[kt][2]); PK4(s[kt][1], 8, pa[kt][3]); }
  bf16* Ow = memo + (tok0 + qb * 256 + wid * 32) * D_MODEL + h * 256 + r32;
  f32x16 o[4] = {};
#pragma unroll
  for (int st = 8; st < 16; ++st) {
    if (st + 1 < 16) MLOAD(st + 1);
    pv_d0(o, vb0 + (st & 1) * SHM_T, pa[st & 3][0], pa[st & 3][1], pa[st & 3][2], pa[st & 3][3]);
    if ((st & 3) == 3) {
#pragma unroll
      for (int d0 = 0; d0 < 4; ++d0)
#pragma unroll
        for (int r = 0; r < 16; ++r) { Ow[(long)crow(r, hi) * D_MODEL + ((st >> 2) & 1) * 128 + d0 * 32] = (bf16)(cvtpk(o[d0][r] * rli[r], 0.f) & 0xffffu); o[d0][r] = 0.f; } }
    if (st + 1 < 16) MWRITE(st + 1);
    __syncthreads();
  }
#undef MLOAD
#undef MWRITE
}
#undef PK4
#undef SBAR
}

#define LAS __attribute__((address_space(3)))
typedef unsigned short bf16;
typedef unsigned v4u __attribute__((ext_vector_type(4)));
typedef float f32x4 __attribute__((ext_vector_type(4)));
constexpr int NWAVES = 8, LDS_BYTES = 147456;
constexpr size_t MiB = 1u << 20;
constexpr size_t WS_WIN = 1 * MiB;
constexpr size_t WS_WOTH = 21 * MiB;
constexpr size_t WOTH_STRIDE = 24 * MiB, WO_OFF = 6 * MiB, W1_OFF = 8 * MiB, W2_OFF = 16 * MiB;
constexpr size_t WS_WMKV = 69 * MiB;
constexpr size_t WS_MEMB = 85 * MiB;
constexpr size_t WS_MKV = 89 * MiB;
constexpr size_t WS_XB = 121 * MiB;
constexpr size_t WS_A3 = 153 * MiB;
constexpr size_t WS_MERGED = 249 * MiB;
constexpr size_t WS_PROJ = 281 * MiB;
constexpr size_t WS_END = 601 * MiB;

__device__ __forceinline__ unsigned f2bf(float f) { unsigned u = __builtin_bit_cast(unsigned, f); return (u + 0x7fffu + ((u >> 16) & 1u)) >> 16; }
__device__ __forceinline__ unsigned pk2(float lo, float hi) { return f2bf(lo) | (f2bf(hi) << 16); }
__device__ __forceinline__ float wave_sum(float v) {
#pragma unroll
    for (int o = 1; o < 64; o <<= 1) v += __shfl_xor(v, o);
    return v;
}
__device__ __forceinline__ void transpose_item(const float* __restrict__ W, int K, int N, bf16* __restrict__ WT, LAS float* scr, int item, int lane) {
    const int nblk = N / 32, kb = item / nblk, nb = item % nblk, k0 = 64 * kb, n0 = 32 * nb;
#pragma unroll 8
    for (int i = 0; i < 32; ++i) { const int kk = 2 * i + (lane >> 5); scr[kk * 33 + (lane & 31)] = W[(size_t)(k0 + kk) * N + n0 + (lane & 31)]; }
    asm volatile("s_waitcnt lgkmcnt(0)" ::: "memory");
    const int c = lane & 7;
#pragma unroll
    for (int j = 0; j < 4; ++j) { const int n = (lane >> 3) + 8 * j; const LAS float* s = scr + (8 * c) * 33 + n;
        v4u o; o.x = pk2(s[0 * 33], s[1 * 33]); o.y = pk2(s[2 * 33], s[3 * 33]); o.z = pk2(s[4 * 33], s[5 * 33]); o.w = pk2(s[6 * 33], s[7 * 33]);
        *(v4u*)(WT + (size_t)(n0 + n) * K + k0 + 8 * c) = o; }
    asm volatile("s_waitcnt lgkmcnt(0)" ::: "memory");
}
struct Args { const float* in[19]; float* out; unsigned char* ws; };
enum { I_X = 0, I_MEM, I_WIN, I_BGATE, I_CONVW, I_WCONVOUT, I_LAMBDA, I_SUBLN, I_WDIFFOUT, I_RELBIAS, I_WMEMKV, I_WMEMOUT, I_WO, I_LN1G, I_LN1B, I_WMLP1, I_WMLP2, I_LN2G, I_LN2B };

__device__ __forceinline__ void convert_layer_weights(const Args& a, int l, LAS float* scr, int gw, int NGW, int lane) {
    unsigned char* ws = a.ws;
    bf16* win_t = (bf16*)(ws + WS_WIN); bf16* oth = (bf16*)(ws + WS_WOTH + (size_t)(l & 1) * WOTH_STRIDE);
    constexpr int I_IN = 16 * 320, I_SQ = 16 * 32, I_1 = 16 * 128, I_2 = 64 * 32, NITEMS = I_IN + 4 * I_SQ + I_1 + I_2;
    for (int it = gw; it < NITEMS; it += NGW) {
        int r = it;
        if (r < I_IN) { transpose_item(a.in[I_WIN] + (size_t)l * 1024 * NIN, 1024, NIN, win_t, scr, r, lane); continue; } r -= I_IN;
        if (r < I_SQ) { transpose_item(a.in[I_WCONVOUT] + (size_t)l * 1048576, 1024, 1024, oth, scr, r, lane); continue; } r -= I_SQ;
        if (r < I_SQ) { transpose_item(a.in[I_WDIFFOUT] + (size_t)l * 1048576, 1024, 1024, oth + 1048576, scr, r, lane); continue; } r -= I_SQ;
        if (r < I_SQ) { transpose_item(a.in[I_WMEMOUT] + (size_t)l * 1048576, 1024, 1024, oth + 2 * 1048576, scr, r, lane); continue; } r -= I_SQ;
        if (r < I_SQ) { transpose_item(a.in[I_WO] + (size_t)l * 1048576, 1024, 1024, (bf16*)((unsigned char*)oth + WO_OFF), scr, r, lane); continue; } r -= I_SQ;
        if (r < I_1) { transpose_item(a.in[I_WMLP1] + (size_t)l * 4194304, 1024, 4096, (bf16*)((unsigned char*)oth + W1_OFF), scr, r, lane); continue; } r -= I_1;
        transpose_item(a.in[I_WMLP2] + (size_t)l * 4194304, 4096, 1024, (bf16*)((unsigned char*)oth + W2_OFF), scr, r, lane);
    }
}
__device__ __forceinline__ void cvt_rows(const float* __restrict__ src, bf16* __restrict__ dst, size_t n8, size_t gt, size_t ngt) {
    for (size_t i = gt; i < n8; i += ngt) { const f32x4 a = *(const f32x4*)(src + i * 8), b = *(const f32x4*)(src + i * 8 + 4);
        v4u o; o.x = pk2(a.x, a.y); o.y = pk2(a.z, a.w); o.z = pk2(b.x, b.y); o.w = pk2(b.z, b.w); *(v4u*)(dst + i * 8) = o; }
}
__device__ __forceinline__ void ln_row(const float* vrow, float* orow, bf16* brow, const float* __restrict__ g, const float* __restrict__ bt, int lane) {
    const f32x4* xr = (const f32x4*)vrow + lane;
    f32x4 v[4]; float s = 0.f;
#pragma unroll
    for (int j = 0; j < 4; ++j) { v[j] = xr[64 * j]; s += (v[j].x + v[j].y) + (v[j].z + v[j].w); }
    const float mean = wave_sum(s) * (1.f / 1024.f); float s2 = 0.f;
#pragma unroll
    for (int j = 0; j < 4; ++j) { v[j] = v[j] - mean; s2 += (v[j].x * v[j].x + v[j].y * v[j].y) + (v[j].z * v[j].z + v[j].w * v[j].w); }
    const float rstd = 1.f / sqrtf(wave_sum(s2) * (1.f / 1024.f) + LN_EPS);
    unsigned long long* o8 = (unsigned long long*)brow + lane; f32x4* of = (f32x4*)orow + lane;
#pragma unroll
    for (int j = 0; j < 4; ++j) { const f32x4 gg = *((const f32x4*)g + lane + 64 * j), bb = *((const f32x4*)bt + lane + 64 * j);
        const f32x4 y = v[j] * rstd * gg + bb; of[64 * j] = y;
        o8[64 * j] = (unsigned long long)pk2(y.x, y.y) | ((unsigned long long)pk2(y.z, y.w) << 32); }
}
__device__ __forceinline__ void bf8_to_f32(const v4u& w, float (&f)[8]) {
    f[0] = __uint_as_float(w.x << 16); f[1] = __uint_as_float(w.x & 0xffff0000u); f[2] = __uint_as_float(w.y << 16); f[3] = __uint_as_float(w.y & 0xffff0000u);
    f[4] = __uint_as_float(w.z << 16); f[5] = __uint_as_float(w.z & 0xffff0000u); f[6] = __uint_as_float(w.w << 16); f[7] = __uint_as_float(w.w & 0xffff0000u); }
__device__ __forceinline__ void conv_phase(const bf16* __restrict__ proj, const float* __restrict__ cw, bf16* __restrict__ ain, size_t gt, size_t ngt) {
    for (size_t idx = gt; idx < (size_t)M_TOK * 128; idx += ngt) {
        const int t = (int)(idx >> 7), c8 = (int)(idx & 127) * 8, s = t & (SEQ - 1);
        const bf16* row = proj + (size_t)t * NIN;
        float y[8], hb[8], cb[8];
#pragma unroll
        for (int e = 0; e < 8; ++e) y[e] = 0.f;
#pragma unroll
        for (int j = 0; j < 3; ++j) {
            const int sj = s + j - 1;
            if (sj >= 0 && sj < SEQ) {
                const bf16* rj = row + (long)(j - 1) * NIN;
                bf8_to_f32(*(const v4u*)(rj + COL_CH + c8), hb); bf8_to_f32(*(const v4u*)(rj + COL_CC + c8), cb);
                const f32x4 w0 = *(const f32x4*)(cw + j * 1024 + c8), w1 = *(const f32x4*)(cw + j * 1024 + c8 + 4);
#pragma unroll
                for (int e = 0; e < 4; ++e) { y[e] += w0[e] * (hb[e] * cb[e]); y[4 + e] += w1[e] * (hb[4 + e] * cb[4 + e]); }
            }
        }
        bf8_to_f32(*(const v4u*)(row + COL_CB + c8), cb);
        v4u o; o.x = pk2(cb[0] * y[0], cb[1] * y[1]); o.y = pk2(cb[2] * y[2], cb[3] * y[3]); o.z = pk2(cb[4] * y[4], cb[5] * y[5]); o.w = pk2(cb[6] * y[6], cb[7] * y[7]);
        *(v4u*)(ain + (size_t)t * D_MODEL + c8) = o;
    }
}

__global__ void __launch_bounds__(NWAVES * 64, 2) fwd_megakernel(Args a) {
    extern __shared__ __attribute__((aligned(16))) unsigned char lds[];
    cg::grid_group grid = cg::this_grid();
    const int G = gridDim.x, bx = blockIdx.x, vcu = (G % 8 == 0) ? (bx % 8) * (G / 8) + bx / 8 : bx;
    const int NGW = G * NWAVES; const size_t ngt = (size_t)G * NWAVES * 64;
#define FRESH_TID() int tid = threadIdx.x; asm volatile("" : "+v"(tid)); const int lane = tid & 63, wave = __builtin_amdgcn_readfirstlane(tid >> 6); const int gw = vcu * NWAVES + wave; const size_t gt = (size_t)bx * (NWAVES * 64) + tid; LAS float* scr = (LAS float*)(ldsl + wave * 16384); (void)lane; (void)gw; (void)gt; (void)scr
    unsigned char* ws = a.ws;
    LAS unsigned char* ldsl = (LAS unsigned char*)lds;
    bf16* win_t = (bf16*)(ws + WS_WIN); bf16* wmkv_t = (bf16*)(ws + WS_WMKV); bf16* memb = (bf16*)(ws + WS_MEMB); bf16* mkv = (bf16*)(ws + WS_MKV);
    bf16* xb = (bf16*)(ws + WS_XB); bf16* a3 = (bf16*)(ws + WS_A3); bf16* merged = (bf16*)(ws + WS_MERGED); bf16* proj = (bf16*)(ws + WS_PROJ); bf16* hbuf = proj;
    float* out = a.out;

    { FRESH_TID();
    convert_layer_weights(a, 0, scr, gw, NGW, lane);
    for (int it = gw; it < DEPTH * 16 * 64; it += NGW) { const int l = it / 1024, r = it % 1024;
        transpose_item(a.in[I_WMEMKV] + (size_t)l * 1024 * 2048, 1024, 2048, wmkv_t + (size_t)l * 2048 * 1024, scr, r, lane); }
    cvt_rows(a.in[I_X], xb, (size_t)M_TOK * 1024 / 8, gt, ngt);
    cvt_rows(a.in[I_MEM], memb, (size_t)BATCH * MEM_LEN * 1024 / 8, gt, ngt);
    }
    grid.sync();
    {
        pg8::Gemm g{memb, wmkv_t, BATCH * MEM_LEN, DEPTH * 2048, 1024}; pg8::StaticOrder S; S.init(BATCH * MEM_LEN, DEPTH * 2048, G, bx);
        pg8::EpiBf16<0> E{mkv, MKV_LD};

#ifndef NO_G0
            pg8::gemm_phase<pg8::EpiBf16<0>, pg8::StaticOrder, true, true>(ldsl, g, S, E);
#endif

    }
#pragma unroll 1
    for (int l = 0; l < DEPTH; ++l) {
        bf16* oth = (bf16*)(ws + WS_WOTH + (size_t)(l & 1) * WOTH_STRIDE);
        const float lam_init = 0.8f - 0.6f * expf(-0.3f * (float)l);
        {
            pg8::Gemm g{xb, win_t, M_TOK, NIN, 1024}; pg8::StaticOrder S; S.init(M_TOK, NIN, G, bx);
            pg8::EpiProj E{proj, NIN, a.in[I_BGATE] + (size_t)l * 3072, 0.125f * LOG2E, 0.0625f * LOG2E};

#ifndef NO_GA
            pg8::gemm_phase<pg8::EpiProj, pg8::StaticOrder, true, true>(ldsl, g, S, E);
#endif

        }
        grid.sync();
        {   FRESH_TID();
            conv_phase(proj, a.in[I_CONVW] + (size_t)l * 3072, a3, gt, ngt);
            float* misc = (float*)(lds + att::LDS_MISC);
            if (tid == 0) { const float* lp = a.in[I_LAMBDA] + (size_t)l * 256; float s01 = 0.f, s23 = 0.f;
                for (int i = 0; i < 64; ++i) { s01 += lp[i] * lp[64 + i]; s23 += lp[128 + i] * lp[192 + i]; }
                misc[0] = expf(s01) - expf(s23) + lam_init; }
            __syncthreads();
            const float lam = misc[0];
#ifndef NO_DIFF
            for (int i = 0; i < 4; ++i) { const int id = vcu * 4 + i; if (id >= 1024) break;
                att::diff_unit(proj, a3 + (size_t)M_TOK * 1024, (id >> 4) >> 3, (id >> 4) & 7, id & 15, lam, 1.f - lam_init, a.in[I_SUBLN] + (size_t)l * 128, a.in[I_RELBIAS], (char*)lds); }
#endif
#ifndef NO_MEM
            { const int id = vcu; if (id < 256) att::mem_unit(proj, mkv + (size_t)l * 2048, a3 + (size_t)2 * M_TOK * 1024, (id >> 3) >> 2, (id >> 3) & 3, id & 7, (char*)lds); }
#endif
            __syncthreads();
            if (l + 1 < DEPTH) convert_layer_weights(a, l + 1, scr, gw, NGW, lane);
        }
        grid.sync();
        {
            pg8::Gemm g{a3, oth, 3 * M_TOK, 3 * 1024, 1024}; pg8::MergeOrder S; S.init(M_TOK, 1024, G, bx);
            pg8::EpiMerge E{proj + COL_GL, NIN, merged, 1024};

#ifndef NO_GC
            pg8::gemm_phase<pg8::EpiMerge, pg8::MergeOrder, true, true>(ldsl, g, S, E);
#endif

        }
        grid.sync();
        {
            pg8::Gemm g{merged, (bf16*)((unsigned char*)oth + WO_OFF), M_TOK, 1024, 1024}; pg8::StaticOrder S; S.init(M_TOK, 1024, G, bx);
            pg8::EpiResid E{l == 0 ? a.in[I_X] : out, out, 1024, DN_ALPHA};

#ifndef NO_GD
            pg8::gemm_phase<pg8::EpiResid, pg8::StaticOrder, true, true>(ldsl, g, S, E);
#endif

        }
        grid.sync();
        { FRESH_TID(); for (int m = gw; m < M_TOK; m += NGW) ln_row(out + (size_t)m * 1024, out + (size_t)m * 1024, xb + (size_t)m * 1024, a.in[I_LN1G] + (size_t)l * 1024, a.in[I_LN1B] + (size_t)l * 1024, lane); }
        grid.sync();
        {
            pg8::Gemm g{xb, (bf16*)((unsigned char*)oth + W1_OFF), M_TOK, D_FF, 1024}; pg8::StaticOrder S; S.init(M_TOK, D_FF, G, bx);
            pg8::EpiBf16<1> E{hbuf, D_FF};

#ifndef NO_GE
            pg8::gemm_phase<pg8::EpiBf16<1>, pg8::StaticOrder, true, true>(ldsl, g, S, E);
#endif

        }
        grid.sync();
        {
            pg8::Gemm g{hbuf, (bf16*)((unsigned char*)oth + W2_OFF), M_TOK, 1024, D_FF}; pg8::StaticOrder S; S.init(M_TOK, 1024, G, bx);
            pg8::EpiResid E{out, out, 1024, DN_ALPHA};

#ifndef NO_GD
            pg8::gemm_phase<pg8::EpiResid, pg8::StaticOrder, true, true>(ldsl, g, S, E);
#endif

        }
        grid.sync();
        { FRESH_TID(); for (int m = gw; m < M_TOK; m += NGW) ln_row(out + (size_t)m * 1024, out + (size_t)m * 1024, xb + (size_t)m * 1024, a.in[I_LN2G] + (size_t)l * 1024, a.in[I_LN2B] + (size_t)l * 1024, lane); }
        grid.sync();
    }
}

extern "C" void kernel_launch(void* const* d_in, const int* in_sizes, int n_in, void* d_out, int out_size, void* d_ws, size_t ws_size, hipStream_t stream) {
    static int grid = 0;
    if (grid == 0) {
        if (n_in != 19 || in_sizes[0] != M_TOK * 1024 || out_size != M_TOK * 1024 || ws_size < WS_END) {
            fprintf(stderr, "kernel_launch: unexpected shapes: n_in %d in0 %d out %d ws %zu (need >= %zu)\n", n_in, n_in > 0 ? in_sizes[0] : -1, out_size, ws_size, (size_t)WS_END); grid = -1; return; }
        int dev = 0, cus = 0, per_cu = 0;
        hipGetDevice(&dev); hipDeviceGetAttribute(&cus, hipDeviceAttributeMultiprocessorCount, dev);
        if (hipFuncSetAttribute((const void*)fwd_megakernel, hipFuncAttributeMaxDynamicSharedMemorySize, LDS_BYTES) != hipSuccess) { fprintf(stderr, "kernel_launch: hipFuncSetAttribute failed\n"); grid = -1; return; }
        if (hipOccupancyMaxActiveBlocksPerMultiprocessor(&per_cu, (const void*)fwd_megakernel, NWAVES * 64, LDS_BYTES) != hipSuccess || per_cu < 1) { fprintf(stderr, "kernel_launch: occupancy query says %d blocks per CU\n", per_cu); per_cu = 1; }
        (void)hipGetLastError();
        grid = cus;
        if (grid != 256) fprintf(stderr, "kernel_launch: %d CUs: this kernel is laid out for 256\n", grid);
    }
    if (grid < 0) return;
    Args a{};
    for (int i = 0; i < 19; ++i) a.in[i] = (const float*)d_in[i];
    a.out = (float*)d_out; a.ws = (unsigned char*)d_ws;
    void* args[] = {&a};
    hipError_t e = hipLaunchCooperativeKernel((const void*)fwd_megakernel, dim3(grid), dim3(NWAVES * 64), args, LDS_BYTES, stream);
    if (e != hipSuccess) fprintf(stderr, "kernel_launch: cooperative launch failed: %s (grid %d)\n", hipGetErrorString(e), grid);
}
```

```cpp
#include <hip/hip_runtime.h>
#include <hip/hip_cooperative_groups.h>
#include <cstdio>
#include <cstdint>
namespace cg = cooperative_groups;
namespace pg8 {
#define PG8_LAS __attribute__((address_space(3)))
typedef unsigned short bf16_t;
typedef short bf16x8 __attribute__((ext_vector_type(8)));
typedef float f32x4 __attribute__((ext_vector_type(4)));
typedef unsigned u32x4 __attribute__((ext_vector_type(4)));
constexpr int BM = 256, BK = 64, HALF = 128, HTB = HALF * BK * 2  , STAGE_BYTES = 8 * HTB, NXCD = 8, WGM = 8;

__host__ __device__ __forceinline__ int lds_byte(int r, int c) { const int st = (r >> 4) * 2 + (c >> 5), rr = r & 15, cc = c & 31, ob = rr * 64 + cc * 2; return st * 1024 + (ob ^ (((ob >> 9) & 1) << 5)); }
__host__ __device__ __forceinline__ void stage_rc(int b, int& R, int& C) { const int st = b / 1024, sb = b % 1024, swz = sb ^ (((sb >> 9) & 1) << 5); R = (st >> 1) * 16 + swz / 64; C = (st & 1) * 32 + (swz % 64) / 2; }
__host__ __device__ __forceinline__ int perm32(int rho) { const int n = rho >> 4, i = rho & 15; return 8 * (i >> 2) + 4 * n + (i & 3); }

struct Unit { int pm, pn; };
struct Gemm { const bf16_t* A; const bf16_t* Bt; int M, N, K; };

struct StaticOrder {
    int nM, nN, nwg, G, c;
    __host__ __device__ void init(int M, int N, int G_, int c_) { nM = M / BM; nN = N / BM; nwg = nM * nN; G = G_; c = c_; }
    __host__ __device__ bool next(int i, Unit& u) const {
        const long L = (long)i * G + c; if (L >= nwg) return false;
        int wgid = (int)L; { const int q = nwg / NXCD, r = nwg % NXCD, xcd = wgid % NXCD, off = wgid / NXCD; wgid = (xcd < r ? xcd * (q + 1) : r * (q + 1) + (xcd - r) * q) + off; }
        const int nig = WGM * nN, gid = wgid / nig, fm = gid * WGM, gsz = (nM - fm) < WGM ? (nM - fm) : WGM;
        u.pm = fm + ((wgid % nig) % gsz); u.pn = (wgid % nig) / gsz; return true;
    }
    __device__ __forceinline__ void a_ready(const Unit&) const {}
    __device__ __forceinline__ void done(const Unit&) const {}
};


__device__ __forceinline__ unsigned cvt_pk_bf16(float lo, float hi) { unsigned r; asm volatile("v_cvt_pk_bf16_f32 %0, %1, %2" : "=v"(r) : "v"(lo), "v"(hi)); return r; }
__device__ __forceinline__ u32x4 pack8(const f32x4& v0, const f32x4& v1) { u32x4 w; w.x = cvt_pk_bf16(v0[0], v0[1]); w.y = cvt_pk_bf16(v0[2], v0[3]); w.z = cvt_pk_bf16(v1[0], v1[1]); w.w = cvt_pk_bf16(v1[2], v1[3]); return w; }
__device__ __forceinline__ void unpack8(const u32x4& w, f32x4& v0, f32x4& v1) {
    v0[0] = __uint_as_float(w.x << 16); v0[1] = __uint_as_float(w.x & 0xffff0000u); v0[2] = __uint_as_float(w.y << 16); v0[3] = __uint_as_float(w.y & 0xffff0000u);
    v1[0] = __uint_as_float(w.z << 16); v1[1] = __uint_as_float(w.z & 0xffff0000u); v1[2] = __uint_as_float(w.w << 16); v1[3] = __uint_as_float(w.w & 0xffff0000u); }

template <int ACT  > struct EpiBf16 {
    static constexpr bool PERM = true, AFTER_DRAIN = false;
    bf16_t* O; int ldc;
    __device__ __forceinline__ bool operator()(f32x4 (&acc)[2][2][4][2], const Unit& u, int wr, int wc, int fr, int fq) const {
        const int row0 = u.pm * BM + wr * 64 + fr, col0 = u.pn * BM + wc * 32 + 8 * fq;
#pragma unroll
        for (int ai = 0; ai < 2; ++ai)
#pragma unroll
            for (int m = 0; m < 4; ++m) { bf16_t* rowp = O + (size_t)(row0 + ai * HALF + m * 16) * ldc + col0;
#pragma unroll
                for (int bj = 0; bj < 2; ++bj) { f32x4 v0 = acc[ai][bj][m][0], v1 = acc[ai][bj][m][1];
                    if (ACT == 1) {
#pragma unroll
                        for (int e = 0; e < 4; ++e) { const float a = fmaxf(v0[e], 0.f), b = fmaxf(v1[e], 0.f); v0[e] = a * a; v1[e] = b * b; } }
                    *(u32x4*)(rowp + bj * HALF) = pack8(v0, v1); } }
        return true;
    }
};
struct EpiProj {
    static constexpr bool PERM = true, AFTER_DRAIN = false;
    bf16_t* O; int ldc; const float* bgate; float qscale, mqscale;
    __device__ __forceinline__ bool operator()(f32x4 (&acc)[2][2][4][2], const Unit& u, int wr, int wc, int fr, int fq) const {
        const int row0 = u.pm * BM + wr * 64 + fr, col0 = u.pn * BM + wc * 32 + 8 * fq;
        const int kind = (u.pn >= 28) ? 2 : ((u.pn >= 12 && u.pn < 16) ? 1 : ((u.pn >= 24) ? 3 : 0));
        const float sc = kind == 1 ? qscale : (kind == 3 ? mqscale : 1.f);
        f32x4 bv[2][2];
#pragma unroll
        for (int bj = 0; bj < 2; ++bj)
#pragma unroll
            for (int n = 0; n < 2; ++n) bv[bj][n] = (kind == 2) ? *(const f32x4*)(bgate + (col0 - 7168) + bj * HALF + 4 * n) : (f32x4){0.f, 0.f, 0.f, 0.f};
#pragma unroll
        for (int ai = 0; ai < 2; ++ai)
#pragma unroll
            for (int m = 0; m < 4; ++m) { bf16_t* rowp = O + (size_t)(row0 + ai * HALF + m * 16) * ldc + col0;
#pragma unroll
                for (int bj = 0; bj < 2; ++bj) { f32x4 v0 = acc[ai][bj][m][0], v1 = acc[ai][bj][m][1];
                    if (kind == 2) { v0 = v0 + bv[bj][0]; v1 = v1 + bv[bj][1];
#pragma unroll
                        for (int e = 0; e < 4; ++e) { v0[e] = __builtin_amdgcn_rcpf(1.f + __builtin_amdgcn_exp2f(-1.4426950408889634f * v0[e])); v1[e] = __builtin_amdgcn_rcpf(1.f + __builtin_amdgcn_exp2f(-1.4426950408889634f * v1[e])); } }
                    else { v0 = v0 * sc; v1 = v1 * sc; }
                    *(u32x4*)(rowp + bj * HALF) = pack8(v0, v1); } }
        return true;
    }
};
struct EpiResid {
    static constexpr bool PERM = true, AFTER_DRAIN = false;
    const float* base; float* out; int ldc; float alpha;
    __device__ __forceinline__ bool operator()(f32x4 (&acc)[2][2][4][2], const Unit& u, int wr, int wc, int fr, int fq) const {
        const int row0 = u.pm * BM + wr * 64 + fr, col0 = u.pn * BM + wc * 32 + 8 * fq;
#pragma unroll
        for (int ai = 0; ai < 2; ++ai)
#pragma unroll
            for (int m = 0; m < 4; ++m) { const size_t off = (size_t)(row0 + ai * HALF + m * 16) * ldc + col0;
#pragma unroll
                for (int bj = 0; bj < 2; ++bj) {
                    const f32x4 b0 = *(const f32x4*)(base + off + bj * HALF), b1 = *(const f32x4*)(base + off + bj * HALF + 4);
                    *(f32x4*)(out + off + bj * HALF) = b0 * alpha + acc[ai][bj][m][0]; *(f32x4*)(out + off + bj * HALF + 4) = b1 * alpha + acc[ai][bj][m][1]; } }
        return true;
    }
};
struct EpiMerge {
    static constexpr bool PERM = true, AFTER_DRAIN = false;
    const bf16_t* gates; int ldg; bf16_t* O; int ldc;
    __device__ __forceinline__ bool operator()(f32x4 (&acc)[2][2][4][2], const Unit& u, int wr, int wc, int fr, int fq) const {
        const int br = u.pm >> 6, pm = u.pm & 63, pn = u.pn & 3;
        const int row0 = pm * BM + wr * 64 + fr, col0 = pn * BM + wc * 32 + 8 * fq;
        const float tiny = 1e-30f;
#pragma unroll
        for (int ai = 0; ai < 2; ++ai)
#pragma unroll
            for (int m = 0; m < 4; ++m) { const int row = row0 + ai * HALF + m * 16;
#pragma unroll
                for (int bj = 0; bj < 2; ++bj) { const int col = col0 + bj * HALF;
                    f32x4 g0, g1; unpack8(*(const u32x4*)(gates + (size_t)row * ldg + br * 1024 + col), g0, g1);
#pragma unroll
                    for (int e = 0; e < 4; ++e) { g0[e] = fmaxf(g0[e], tiny); g1[e] = fmaxf(g1[e], tiny); }
                    if (br < 2) { f32x4 h0, h1; unpack8(*(const u32x4*)(gates + (size_t)row * ldg + (br + 1) * 1024 + col), h0, h1);
#pragma unroll
                        for (int e = 0; e < 4; ++e) { g0[e] = g0[e] * __builtin_amdgcn_rcpf(fmaxf(h0[e], tiny)); g1[e] = g1[e] * __builtin_amdgcn_rcpf(fmaxf(h1[e], tiny)); } }
                    acc[ai][bj][m][0] = acc[ai][bj][m][0] * g0; acc[ai][bj][m][1] = acc[ai][bj][m][1] * g1;
                    if (br == 2) *(u32x4*)(O + (size_t)row * ldc + col) = pack8(acc[ai][bj][m][0], acc[ai][bj][m][1]); } }
        return br == 2;
    }
};
struct MergeOrder {
    StaticOrder base;
    __host__ __device__ void init(int M, int N, int G_, int c_) { base.init(M, N, G_, c_); }
    __host__ __device__ bool next(int i, Unit& u) const { const int j = i / 3, br = i - 3 * j; Unit t; if (!base.next(j, t)) return false; u.pm = t.pm + 64 * br; u.pn = t.pn + 4 * br; return true; }
    __device__ __forceinline__ void a_ready(const Unit&) const {}
    __device__ __forceinline__ void done(const Unit&) const {}
};
template <class Epi, class Sched, bool ALIGN_EPI = false, bool SP2 = false>
__device__ __forceinline__ void gemm_phase(PG8_LAS unsigned char* lds, const Gemm g, const Sched& S, const Epi& E) {
    int tid = threadIdx.x; asm volatile("" : "+v"(tid));
    const int wid = __builtin_amdgcn_readfirstlane(tid >> 6), lane = tid & 63, wr = wid >> 2, wc = wid & 3, fr = lane & 15, fq = lane >> 4;
    const int K = g.K, nt = K / BK;
    unsigned voffA[2], voffB[2];
#pragma unroll
    for (int i = 0; i < 2; ++i) { int R, C; stage_rc(tid * 16 + i * 8192, R, C); const int Rb = Epi::PERM ? ((R & ~31) + perm32(R & 31)) : R;
        voffA[i] = (unsigned)(R * K + C) * 2u; voffB[i] = (unsigned)(Rb * K + C) * 2u; }
    const size_t kstep = (size_t)(BK * 2);
    const size_t hstep = (size_t)HALF * K * 2;
    const size_t tstep = 2 * hstep;
    const unsigned ldsw = (unsigned)wid * 1024u;
    const int aoff = lds_byte(wr * 64 + fr, fq * 8), boff = lds_byte(wc * 32 + fr, fq * 8);
#define PG8_SA(b, h) (((b) * 2 + (h)) * HTB)
#define PG8_SB(b, h) ((4 + (b) * 2 + (h)) * HTB)
#define PG8_STAGE(bufoff, gbase, voff) do { _Pragma("unroll") for (int _i = 0; _i < 2; ++_i) \
        __builtin_amdgcn_global_load_lds((const unsigned*)((const char*)(gbase) + (voff)[_i]), (PG8_LAS unsigned*)(lds + (bufoff) + ldsw + _i * 8192), 16, 0, 0); } while (0)
#define PG8_LDA(dst, b, h) do { _Pragma("unroll") for (int m = 0; m < 4; ++m) _Pragma("unroll") for (int k = 0; k < 2; ++k) dst[m][k] = *(const PG8_LAS bf16x8*)(lds + PG8_SA(b, h) + aoff + m * 2048 + k * 1024); } while (0)
#define PG8_LDB(dst, b, h) do { _Pragma("unroll") for (int n = 0; n < 2; ++n) _Pragma("unroll") for (int k = 0; k < 2; ++k) dst[n][k] = *(const PG8_LAS bf16x8*)(lds + PG8_SB(b, h) + boff + n * 2048 + k * 1024); } while (0)
#define PG8_MMA(ai, bj, At, Bt) do { __builtin_amdgcn_s_setprio(1); _Pragma("unroll") for (int m = 0; m < 4; ++m) _Pragma("unroll") for (int n = 0; n < 2; ++n) _Pragma("unroll") for (int k = 0; k < 2; ++k) \
        acc[ai][bj][m][n] = __builtin_amdgcn_mfma_f32_16x16x32_bf16(Bt[n][k], At[m][k], acc[ai][bj][m][n], 0, 0, 0); __builtin_amdgcn_s_setprio(0); } while (0)
#define PG8_WAIT_V(n) asm volatile("s_waitcnt vmcnt(" #n ")" ::: "memory")
#define PG8_WAIT_L(n) asm volatile("s_waitcnt lgkmcnt(" #n ")" ::: "memory")
#define PG8_BAR __builtin_amdgcn_s_barrier()
#define PG8_SCHED __builtin_amdgcn_sched_barrier(0)
    Unit cur, nxt; int ui = 0;
    if (!S.next(0, cur)) return;
    f32x4 acc[2][2][4][2];
#pragma unroll
    for (int a = 0; a < 2; ++a)
#pragma unroll
        for (int b = 0; b < 2; ++b)
#pragma unroll
            for (int m = 0; m < 4; ++m)
#pragma unroll
                for (int n = 0; n < 2; ++n) acc[a][b][m][n] = (f32x4){0.f, 0.f, 0.f, 0.f};
    bf16x8 At[4][2], B0[2][2], B1[2][2];
    const char* cA = (const char*)g.A + (size_t)cur.pm * tstep; const char* cB = (const char*)g.Bt + (size_t)cur.pn * tstep;
    S.a_ready(cur);
    if constexpr (SP2) {
        PG8_STAGE(PG8_SB(0, 0), cB, voffB); PG8_STAGE(PG8_SB(0, 1), cB + hstep, voffB); PG8_STAGE(PG8_SA(0, 0), cA, voffA); PG8_STAGE(PG8_SA(0, 1), cA + hstep, voffA);
        if (wr == 1) PG8_BAR;
        PG8_WAIT_V(2); PG8_BAR;
        PG8_STAGE(PG8_SB(1, 0), cB + kstep, voffB); PG8_STAGE(PG8_SA(1, 0), cA + kstep, voffA); PG8_STAGE(PG8_SB(1, 1), cB + hstep + kstep, voffB);
        PG8_WAIT_V(6); PG8_BAR;
    } else {
        PG8_STAGE(PG8_SB(0, 0), cB, voffB); PG8_STAGE(PG8_SA(0, 0), cA, voffA); PG8_STAGE(PG8_SB(0, 1), cB + hstep, voffB); PG8_STAGE(PG8_SA(0, 1), cA + hstep, voffA);
        if (wr == 1) PG8_BAR;
        PG8_WAIT_V(4); PG8_BAR;
        PG8_STAGE(PG8_SB(1, 0), cB + kstep, voffB); PG8_STAGE(PG8_SA(1, 0), cA + kstep, voffA); PG8_STAGE(PG8_SB(1, 1), cB + hstep + kstep, voffB);
        PG8_WAIT_V(6); PG8_BAR;
    }
    for (;;) {
        const bool has_next = S.next(ui + 1, nxt);
        const char* nA = has_next ? (const char*)g.A + (size_t)nxt.pm * tstep : cA; const char* nB = has_next ? (const char*)g.Bt + (size_t)nxt.pn * tstep : cB;
        for (int t = 0; t < nt; t += 2) {
            const bool last = (t == nt - 2);
            const char* a1 = cA + (size_t)(t + 1) * kstep;
            const char* a2 = last ? nA : cA + (size_t)(t + 2) * kstep; const char* b2 = last ? nB : cB + (size_t)(t + 2) * kstep;
            const char* a3 = a2 + kstep; const char* b3 = b2 + kstep;
            if (last && has_next) S.a_ready(nxt);
            if constexpr (SP2) {
            PG8_LDB(B0, 0, 0); PG8_LDB(B1, 0, 1); PG8_SCHED; PG8_LDA(At, 0, 0); PG8_STAGE(PG8_SA(1, 1), a1 + hstep, voffA);
            PG8_WAIT_V(8); PG8_WAIT_L(0); PG8_BAR; PG8_MMA(0, 0, At, B0); PG8_MMA(0, 1, At, B1); PG8_BAR; PG8_SCHED;
            PG8_LDA(At, 0, 1); PG8_STAGE(PG8_SB(0, 0), b2, voffB); PG8_STAGE(PG8_SB(0, 1), b2 + hstep, voffB); PG8_STAGE(PG8_SA(0, 0), a2, voffA);
            PG8_WAIT_V(8); PG8_WAIT_L(0); PG8_BAR; PG8_MMA(1, 0, At, B0); PG8_MMA(1, 1, At, B1); PG8_BAR; PG8_SCHED;
            PG8_LDB(B0, 1, 0); PG8_LDB(B1, 1, 1); PG8_SCHED; PG8_LDA(At, 1, 0); PG8_STAGE(PG8_SA(0, 1), a2 + hstep, voffA);
            PG8_WAIT_V(8); PG8_WAIT_L(0); PG8_BAR; PG8_MMA(0, 0, At, B0); PG8_MMA(0, 1, At, B1); PG8_BAR; PG8_SCHED;
            PG8_LDA(At, 1, 1); PG8_STAGE(PG8_SB(1, 0), b3, voffB); PG8_STAGE(PG8_SB(1, 1), b3 + hstep, voffB); PG8_STAGE(PG8_SA(1, 0), a3, voffA);
            PG8_WAIT_V(8); PG8_WAIT_L(0); PG8_BAR; PG8_MMA(1, 0, At, B0); PG8_MMA(1, 1, At, B1); PG8_BAR; PG8_SCHED;
            } else {
            PG8_LDB(B0, 0, 0); PG8_SCHED; PG8_LDA(At, 0, 0); PG8_STAGE(PG8_SA(1, 1), a1 + hstep, voffA);
            PG8_WAIT_L(8); PG8_BAR; PG8_WAIT_L(0); PG8_MMA(0, 0, At, B0); PG8_BAR; PG8_SCHED;
            PG8_LDB(B1, 0, 1); PG8_STAGE(PG8_SB(0, 0), b2, voffB);
            PG8_BAR; PG8_WAIT_L(0); PG8_MMA(0, 1, At, B1); PG8_BAR;
            PG8_LDA(At, 0, 1); PG8_STAGE(PG8_SA(0, 0), a2, voffA);
            PG8_BAR; PG8_WAIT_L(0); PG8_MMA(1, 0, At, B0); PG8_BAR; PG8_SCHED;
            PG8_STAGE(PG8_SB(0, 1), b2 + hstep, voffB);
            PG8_WAIT_V(6); PG8_BAR; PG8_MMA(1, 1, At, B1); PG8_BAR;
            PG8_LDB(B0, 1, 0); PG8_SCHED; PG8_LDA(At, 1, 0); PG8_STAGE(PG8_SA(0, 1), a2 + hstep, voffA);
            PG8_WAIT_L(8); PG8_BAR; PG8_WAIT_L(0); PG8_MMA(0, 0, At, B0); PG8_BAR; PG8_SCHED;
            PG8_LDB(B1, 1, 1); PG8_STAGE(PG8_SB(1, 0), b3, voffB);
            PG8_BAR; PG8_WAIT_L(0); PG8_MMA(0, 1, At, B1); PG8_BAR;
            PG8_LDA(At, 1, 1); PG8_STAGE(PG8_SA(1, 0), a3, voffA);
            PG8_BAR; PG8_WAIT_L(0); PG8_MMA(1, 0, At, B0); PG8_BAR; PG8_SCHED;
            PG8_STAGE(PG8_SB(1, 1), b3 + hstep, voffB);
            PG8_WAIT_V(6); PG8_BAR; PG8_MMA(1, 1, At, B1); PG8_BAR;
            }
        }
        if constexpr (ALIGN_EPI) { if (wr == 0) PG8_BAR; }
        bool reset_ = true; if constexpr (!Epi::AFTER_DRAIN) { reset_ = E(acc, cur, wr, wc, fr, fq); S.done(cur); }
        if (!has_next) break;
        if (reset_)
#pragma unroll
        for (int a = 0; a < 2; ++a)
#pragma unroll
            for (int b = 0; b < 2; ++b)
#pragma unroll
                for (int m = 0; m < 4; ++m)
#pragma unroll
                    for (int n = 0; n < 2; ++n) acc[a][b][m][n] = (f32x4){0.f, 0.f, 0.f, 0.f};
        cur = nxt; cA = nA; cB = nB; ++ui;
        if constexpr (ALIGN_EPI) { if (wr == 1) PG8_BAR; }
    }
    PG8_WAIT_V(0);
    if constexpr (!ALIGN_EPI) { if (wr == 0) PG8_BAR; }
    PG8_BAR;
    if constexpr (Epi::AFTER_DRAIN) { E.fused(acc, cur, wr, wc, fr, fq, lds, wid, lane); S.done(cur); }
#undef PG8_SA
#undef PG8_SB
#undef PG8_STAGE
#undef PG8_LDA
#undef PG8_LDB
#undef PG8_MMA
#undef PG8_WAIT_V
#undef PG8_WAIT_L
#undef PG8_BAR
#undef PG8_SCHED
}
}

constexpr int D_MODEL = 1024, BATCH = 8, SEQ = 2048, DEPTH = 4, MEM_LEN = 256, NIN = 10240, D_FF = 4096;
constexpr int M_TOK = BATCH * SEQ;
constexpr int COL_CH = 0, COL_CB = 1024, COL_CC = 2048, COL_DQ = 3072, COL_DK = 4096, COL_DV = 5120, COL_MQ = 6144, COL_GL = 7168;
constexpr float LN_EPS = 1e-5f, LOG2E = 1.4426950408889634f;
constexpr float DN_ALPHA = 1.681792830507429f;
constexpr int MKV_LD = DEPTH * 2048;

namespace att {
using bf16 = unsigned short;
using bf16x8 = __attribute__((ext_vector_type(8))) short;
using s16x4  = __attribute__((ext_vector_type(4))) short;
using f32x16 = __attribute__((ext_vector_type(16))) float;
using u32x4  = __attribute__((ext_vector_type(4))) unsigned;
constexpr int KVBLK = 64;
constexpr int SHM_T = 16384;
constexpr int LDS_WS = 65536, LDS_TBL = 65536 + 2048, LDS_MISC = 65536 + 2048 + 1280;
#define KSWZ(row, colB) ((row) * 256 + ((colB) ^ (((row) & 7) << 4)))
#define SBAR() __builtin_amdgcn_sched_barrier(0)
constexpr float THR = 8.f;
__device__ __forceinline__ int crow(int r, int hi) { return (r & 3) + 8 * (r >> 2) + 4 * hi; }
__device__ __forceinline__ unsigned cvtpk(float lo, float hi) { unsigned r; asm volatile("v_cvt_pk_bf16_f32 %0, %1, %2" : "=v"(r) : "v"(lo), "v"(hi)); return r; }
__device__ __forceinline__ bf16x8 ld8(const bf16* p) { return *reinterpret_cast<const bf16x8*>(p); }

__device__ __forceinline__ int t5_bucket(int rel) {
  const int n = rel < 0 ? -rel : rel; int v;
  if (n < 8) v = n; else if (n < 12) v = 8; else if (n < 16) v = 9; else if (n < 23) v = 10; else if (n < 32) v = 11; else if (n < 46) v = 12; else if (n < 64) v = 13; else if (n < 91) v = 14; else v = 15;
  return (rel > 0 ? 16 : 0) + v;
}
__device__ __forceinline__ void add_bias(f32x16& p0, f32x16& p1, int key0, int qw0, int r32, int hi, const float* tbl) {
  const int dmin = key0 - qw0 - 31, dmax = key0 + 63 - qw0;
  if (dmin >= 128) { const float c = tbl[256];
#pragma unroll
    for (int r = 0; r < 16; ++r) { p0[r] += c; p1[r] += c; } }
  else if (dmax <= -128) { const float c = tbl[0];
#pragma unroll
    for (int r = 0; r < 16; ++r) { p0[r] += c; p1[r] += c; } }
  else { const int base = key0 - qw0 - r32 + 128 + 4 * hi;
#pragma unroll
    for (int r = 0; r < 16; ++r) { const int d = base + (r & 3) + 8 * (r >> 2); const int i0 = min(max(d, 0), 256), i1 = min(max(d + 32, 0), 256); p0[r] += tbl[i0]; p1[r] += tbl[i1]; } }
}
__device__ __forceinline__ void partialSM(f32x16& p0, f32x16& p1, float& m_reg, float& mn, float& alpha) {
  float pmax = p0[0];
#pragma unroll
  for (int r = 1; r < 16; ++r) pmax = fmaxf(pmax, p0[r]);
#pragma unroll
  for (int r = 0; r < 16; ++r) pmax = fmaxf(pmax, p1[r]);
  { auto rr = __builtin_amdgcn_permlane32_swap(__float_as_uint(pmax), __float_as_uint(pmax), false, false);
    pmax = fmaxf(__uint_as_float(rr[0]), __uint_as_float(rr[1])); }
  if (__builtin_expect(__all(pmax - m_reg <= THR), 1)) { mn = m_reg; alpha = 1.f; }
  else { mn = fmaxf(m_reg, pmax); alpha = __builtin_amdgcn_exp2f(m_reg - mn); m_reg = mn; }
#pragma unroll
  for (int r = 0; r < 16; ++r) { p0[r] -= mn; p1[r] -= mn; }
#pragma unroll
  for (int r = 0; r < 16; ++r) p0[r] = __builtin_amdgcn_exp2f(p0[r]);
}
#define PK4(P, BASE, OUT) do { unsigned a0 = cvtpk(P[BASE + 0], P[BASE + 1]), a1 = cvtpk(P[BASE + 2], P[BASE + 3]);   \
    unsigned b0 = cvtpk(P[BASE + 4], P[BASE + 5]), b1 = cvtpk(P[BASE + 6], P[BASE + 7]);                              \
    auto r0 = __builtin_amdgcn_permlane32_swap(a0, b0, false, false); auto r1 = __builtin_amdgcn_permlane32_swap(a1, b1, false, false); \
    u32x4 w = {r0[0], r1[0], r0[1], r1[1]}; OUT = *reinterpret_cast<bf16x8*>(&w); } while (0)
__device__ __forceinline__ void finishSM(f32x16& p0, f32x16& p1, float alpha, float& l_reg, bf16x8& pa0, bf16x8& pa1, bf16x8& pa2, bf16x8& pa3) {
#pragma unroll
  for (int r = 0; r < 16; ++r) p1[r] = __builtin_amdgcn_exp2f(p1[r]);
  float ps = 0;
#pragma unroll
  for (int r = 0; r < 16; ++r) ps += p0[r];
#pragma unroll
  for (int r = 0; r < 16; ++r) ps += p1[r];
  { auto rr = __builtin_amdgcn_permlane32_swap(__float_as_uint(ps), __float_as_uint(ps), false, false);
    ps = __uint_as_float(rr[0]) + __uint_as_float(rr[1]); }
  l_reg = l_reg * alpha + ps;
  PK4(p0, 0, pa0); PK4(p0, 8, pa1); PK4(p1, 0, pa2); PK4(p1, 8, pa3);
}
template <int NS, bool ZERO> __device__ __forceinline__ void qkt(f32x16& p0, f32x16& p1, const char* Ks, const bf16x8* qr, int cb0, int r32, int hi) {
  if (ZERO) { p0 = f32x16{}; p1 = f32x16{}; }
#pragma unroll
  for (int d0 = 0; d0 < NS; ++d0) { const int cb = cb0 + (d0 * 16 + hi * 8) * 2;
    bf16x8 b0 = *reinterpret_cast<const bf16x8*>(Ks + KSWZ(r32, cb));
    bf16x8 b1 = *reinterpret_cast<const bf16x8*>(Ks + KSWZ(32 + r32, cb));
    p0 = __builtin_amdgcn_mfma_f32_32x32x16_bf16(b0, qr[d0], p0, 0, 0, 0);
    p1 = __builtin_amdgcn_mfma_f32_32x32x16_bf16(b1, qr[d0], p1, 0, 0, 0); }
}
__device__ __forceinline__ int v_st(int k, int c) { const int kk = (k & ~0xC) | ((k & 4) << 1) | ((k & 8) >> 1); return ((kk >> 3) * 4 + (c >> 5)) * 512 + ((kk & 7) * 32 + (c & 31)) * 2; }
__device__ __forceinline__ int v_rd_base(int lane) { return ((lane & 3) << 3) | (((lane >> 2) & 3) << 6) | (((lane >> 4) & 1) << 5) | (((lane >> 5) & 1) << 8); }
constexpr int v_rd_off(int d0, int ks, int half) { return d0 * 512 + ks * 4096 + half * 2048; }
template <int OFF> __device__ __forceinline__ s16x4 tr_read(int vb) {
  s16x4 r; asm volatile("ds_read_b64_tr_b16 %0, %1 offset:%2" : "=&v"(r) : "v"(vb), "i"(OFF) : "memory"); return r;
}
template <int D0> __device__ __forceinline__ void pv_one(f32x16& od, int vb, bf16x8 pa0, bf16x8 pa1, bf16x8 pa2, bf16x8 pa3) {
  const s16x4 l0 = tr_read<v_rd_off(D0, 0, 0)>(vb), h0 = tr_read<v_rd_off(D0, 0, 1)>(vb), l1 = tr_read<v_rd_off(D0, 1, 0)>(vb), h1 = tr_read<v_rd_off(D0, 1, 1)>(vb);
  const s16x4 l2 = tr_read<v_rd_off(D0, 2, 0)>(vb), h2 = tr_read<v_rd_off(D0, 2, 1)>(vb), l3 = tr_read<v_rd_off(D0, 3, 0)>(vb), h3 = tr_read<v_rd_off(D0, 3, 1)>(vb);
  asm volatile("s_waitcnt lgkmcnt(0)" ::: "memory"); SBAR();
#define PKV(L, H) (bf16x8){L[0], L[1], L[2], L[3], H[0], H[1], H[2], H[3]}
  od = __builtin_amdgcn_mfma_f32_32x32x16_bf16(pa0, PKV(l0, h0), od, 0, 0, 0);
  od = __builtin_amdgcn_mfma_f32_32x32x16_bf16(pa1, PKV(l1, h1), od, 0, 0, 0);
  od = __builtin_amdgcn_mfma_f32_32x32x16_bf16(pa2, PKV(l2, h2), od, 0, 0, 0);
  od = __builtin_amdgcn_mfma_f32_32x32x16_bf16(pa3, PKV(l3, h3), od, 0, 0, 0);
#undef PKV
}
__device__ __forceinline__ void pv_d0(f32x16* o, int vb, bf16x8 pa0, bf16x8 pa1, bf16x8 pa2, bf16x8 pa3) {
  pv_one<0>(o[0], vb, pa0, pa1, pa2, pa3); pv_one<1>(o[1], vb, pa0, pa1, pa2, pa3); pv_one<2>(o[2], vb, pa0, pa1, pa2, pa3); pv_one<3>(o[3], vb, pa0, pa1, pa2, pa3);
}

__device__ __forceinline__ void diff_unit(const bf16* __restrict__ proj, bf16* __restrict__ att_out, int b, int h, int qb, float lam, float post,
                                          const float* __restrict__ subln_g, const float* __restrict__ rel_bias, char* lds) {
  int tid = threadIdx.x; asm volatile("" : "+v"(tid));
  const int wid = __builtin_amdgcn_readfirstlane(tid >> 6), lane = tid & 63, r32 = lane & 31, hi = lane >> 5, map = wid >> 2, wq = wid & 3;
  char* V_lds = lds; char* K_lds = lds + 2 * SHM_T;
  float* ws = (float*)(lds + LDS_WS) + wid * 64; float* li_l = ws; float* al_l = ws + 32;
  float* tbl = (float*)(lds + LDS_TBL);
  if (tid < 257) tbl[tid] = rel_bias[t5_bucket(tid - 128) * 8 + h] * LOG2E;
  const long tok0 = (long)b * SEQ;
  const bf16* Qw = proj + (tok0 + qb * 128 + wq * 32 + r32) * NIN + COL_DQ + h * 128 + map * 64 + hi * 8;
  const bf16* Kh = proj + tok0 * NIN + COL_DK + h * 128;
  const bf16* Vh = proj + tok0 * NIN + COL_DV + h * 128;
  float m_reg = -1e30f, l_reg = 0; f32x16 o[4] = {}; bf16x8 qr[4];
#pragma unroll
  for (int d0 = 0; d0 < 4; ++d0) qr[d0] = ld8(Qw + d0 * 16);
  const int sr = tid >> 4, sc = (tid & 15) * 8, vst0 = v_st(sr, sc), vst1 = v_st(32 + sr, sc);
  const int vb0 = (int)(uintptr_t)V_lds + v_rd_base(lane);
  const int qw0 = qb * 128 + wq * 32, cbm = map * 128;
  struct { bf16x8 vs0, vs1, ks0, ks1; } sr_[2];
#define SLOAD(i, k0) do { sr_[i].vs0 = ld8(&Vh[(long)((k0) + sr) * NIN + sc]); sr_[i].vs1 = ld8(&Vh[(long)((k0) + 32 + sr) * NIN + sc]); \
    sr_[i].ks0 = ld8(&Kh[(long)((k0) + sr) * NIN + sc]); sr_[i].ks1 = ld8(&Kh[(long)((k0) + 32 + sr) * NIN + sc]); } while (0)
#define SWRITE(bb, i) do { *(bf16x8*)(V_lds + (bb) * SHM_T + vst0) = sr_[i].vs0;          \
    *(bf16x8*)(V_lds + (bb) * SHM_T + vst1) = sr_[i].vs1; const int kc = sc * 2;               \
    *(bf16x8*)(K_lds + (bb) * SHM_T + KSWZ(sr, kc)) = sr_[i].ks0;                       \
    *(bf16x8*)(K_lds + (bb) * SHM_T + KSWZ(32 + sr, kc)) = sr_[i].ks1; } while (0)
#define SWAIT() asm volatile("s_waitcnt vmcnt(4)" ::: "memory")
#define RESC(a) do { if (__any((a) < 1.f)) { if (hi == 0) al_l[r32] = (a); asm volatile("s_waitcnt lgkmcnt(0)" ::: "memory"); \
    _Pragma("unroll") for (int d = 0; d < 4; ++d) _Pragma("unroll") for (int r = 0; r < 16; ++r) o[d][r] *= al_l[crow(r, hi)]; } } while (0)
  f32x16 pA0, pA1, pB0, pB1; float mnA, mnB, alA, alB; bf16x8 pa0, pa1, pa2, pa3; constexpr int NT = SEQ / KVBLK;
  SLOAD(0, 0); asm volatile("s_waitcnt vmcnt(0)" ::: "memory"); SWRITE(0, 0); __syncthreads();
  qkt<4, true>(pA0, pA1, K_lds, qr, cbm, r32, hi); add_bias(pA0, pA1, 0, qw0, r32, hi, tbl); partialSM(pA0, pA1, m_reg, mnA, alA);
  SLOAD(1, KVBLK); SLOAD(0, 2 * KVBLK);
  SWAIT(); SWRITE(1, 1); __syncthreads();
  for (int j = 1; j + 1 < NT; j += 2) {
    SBAR(); qkt<4, true>(pB0, pB1, K_lds + SHM_T, qr, cbm, r32, hi);
    finishSM(pA0, pA1, alA, l_reg, pa0, pa1, pa2, pa3); SBAR();
    SLOAD(1, (j + 2) * KVBLK); SBAR();
    pv_d0(o, vb0, pa0, pa1, pa2, pa3); add_bias(pB0, pB1, j * KVBLK, qw0, r32, hi, tbl); partialSM(pB0, pB1, m_reg, mnB, alB);
    __syncthreads(); SWAIT(); SWRITE(0, 0);
    RESC(alB); __syncthreads();
    SBAR(); qkt<4, true>(pA0, pA1, K_lds, qr, cbm, r32, hi);
    finishSM(pB0, pB1, alB, l_reg, pa0, pa1, pa2, pa3); SBAR();
    if (j + 3 < NT) SLOAD(0, (j + 3) * KVBLK); SBAR();
    pv_d0(o, vb0 + SHM_T, pa0, pa1, pa2, pa3); add_bias(pA0, pA1, (j + 1) * KVBLK, qw0, r32, hi, tbl); partialSM(pA0, pA1, m_reg, mnA, alA);
    __syncthreads(); SWAIT(); SWRITE(1, 1);
    RESC(alA); __syncthreads();
  }
  SBAR(); qkt<4, true>(pB0, pB1, K_lds + SHM_T, qr, cbm, r32, hi);
  finishSM(pA0, pA1, alA, l_reg, pa0, pa1, pa2, pa3); SBAR();
  pv_d0(o, vb0, pa0, pa1, pa2, pa3); add_bias(pB0, pB1, (NT - 1) * KVBLK, qw0, r32, hi, tbl); partialSM(pB0, pB1, m_reg, mnB, alB);
  __syncthreads(); RESC(alB);
  finishSM(pB0, pB1, alB, l_reg, pa0, pa1, pa2, pa3); SBAR();
  pv_d0(o, vb0 + SHM_T, pa0, pa1, pa2, pa3);
  if (hi == 0) li_l[r32] = l_reg; asm volatile("s_waitcnt lgkmcnt(0)" ::: "memory");
  float rli[16];
#pragma unroll
  for (int r = 0; r < 16; ++r) rli[r] = __builtin_amdgcn_rcpf(li_l[crow(r, hi)]);
#pragma unroll
  for (int d0 = 0; d0 < 4; ++d0)
#pragma unroll
    for (int r = 0; r < 16; ++r) o[d0][r] *= rli[r];
  __syncthreads();
  float* X = (float*)lds;
  if (map == 1) {
#pragma unroll
    for (int d0 = 0; d0 < 4; ++d0)
#pragma unroll
      for (int r = 0; r < 16; ++r) X[((wq * 4 + d0) * 16 + r) * 64 + lane] = o[d0][r];
  }
  __syncthreads();
  if (map == 0) {
    float rs[16];
#pragma unroll
    for (int r = 0; r < 16; ++r) { float ss = 0.f;
#pragma unroll
      for (int d0 = 0; d0 < 4; ++d0) { o[d0][r] -= lam * X[((wq * 4 + d0) * 16 + r) * 64 + lane]; ss += o[d0][r] * o[d0][r]; }
      ss += __shfl_xor(ss, 1); ss += __shfl_xor(ss, 2); ss += __shfl_xor(ss, 4); ss += __shfl_xor(ss, 8); ss += __shfl_xor(ss, 16);
      rs[r] = post / sqrtf(ss * (1.f / 128.f) + LN_EPS); }
    bf16* Ow = att_out + (tok0 + qb * 128 + wq * 32) * D_MODEL + h * 128 + r32;
#pragma unroll
    for (int d0 = 0; d0 < 4; ++d0) { const float g = subln_g[d0 * 32 + r32];
#pragma unroll
      for (int r = 0; r < 16; ++r) Ow[(long)crow(r, hi) * D_MODEL + d0 * 32] = (bf16)(cvtpk(o[d0][r] * rs[r] * g, 0.f) & 0xffffu); }
  }
  __syncthreads();
#undef SLOAD
#undef SWRITE
#undef SWAIT
#undef RESC
}

__device__ __forceinline__ void mem_unit(const bf16* __restrict__ proj, const bf16* __restrict__ mkv, bf16* __restrict__ memo, int b, int h, int qb, char* lds) {
  int tid = threadIdx.x; asm volatile("" : "+v"(tid));
  const int wid = __builtin_amdgcn_readfirstlane(tid >> 6), lane = tid & 63, r32 = lane & 31, hi = lane >> 5;
  float* ws = (float*)(lds + LDS_WS) + wid * 64; float* li_l = ws;
  const long tok0 = (long)b * SEQ;
  const bf16* Qw = proj + (tok0 + qb * 256 + wid * 32 + r32) * NIN + COL_MQ + h * 256 + hi * 8;
  const bf16* Kb = mkv + (long)(b * MEM_LEN) * MKV_LD + h * 256;
  const bf16* Vb = Kb + 1024;
  const int sr = tid >> 4, sc = (tid & 15) * 8, vst0 = v_st(sr, sc), vst1 = v_st(32 + sr, sc), kst0 = KSWZ(sr, sc * 2), kst1 = KSWZ(32 + sr, sc * 2);
  const int vb0 = (int)(uintptr_t)lds + v_rd_base(lane);
  f32x16 s[4][2]; bf16x8 qr[8]; bf16x8 g0, g1;
#define MLOAD(st) do { const bf16* src_ = ((st) < 8 ? Kb : Vb) + (long)(((st) & 3) * 64 + sr) * MKV_LD + (((st) >> 2) & 1) * 128 + sc; g0 = ld8(src_); g1 = ld8(src_ + 32L * MKV_LD); } while (0)
#define MWRITE(st) do { char* dst_ = lds + ((st) & 1) * SHM_T; if ((st) < 8) { *(bf16x8*)(dst_ + kst0) = g0; *(bf16x8*)(dst_ + kst1) = g1; } else { *(bf16x8*)(dst_ + vst0) = g0; *(bf16x8*)(dst_ + vst1) = g1; } } while (0)
  MLOAD(0); MWRITE(0); __syncthreads();
#pragma unroll
  for (int st = 0; st < 8; ++st) {
    MLOAD(st + 1);
    if ((st & 3) == 0) {
#pragma unroll
      for (int d0 = 0; d0 < 8; ++d0) qr[d0] = ld8(Qw + (st >> 2) * 128 + d0 * 16); }
    if (st < 4) qkt<8, true>(s[st & 3][0], s[st & 3][1], lds + (st & 1) * SHM_T, qr, 0, r32, hi);
    else        qkt<8, false>(s[st & 3][0], s[st & 3][1], lds + (st & 1) * SHM_T, qr, 0, r32, hi);
    MWRITE(st + 1); __syncthreads();
  }
  float mx = s[0][0][0];
#pragma unroll
  for (int kt = 0; kt < 4; ++kt)
#pragma unroll
    for (int j = 0; j < 2; ++j)
#pragma unroll
      for (int r = 0; r < 16; ++r) mx = fmaxf(mx, s[kt][j][r]);
  { auto rr = __builtin_amdgcn_permlane32_swap(__float_as_uint(mx), __float_as_uint(mx), false, false); mx = fmaxf(__uint_as_float(rr[0]), __uint_as_float(rr[1])); }
  float ps = 0.f;
#pragma unroll
  for (int kt = 0; kt < 4; ++kt)
#pragma unroll
    for (int j = 0; j < 2; ++j)
#pragma unroll
      for (int r = 0; r < 16; ++r) { const float e = __builtin_amdgcn_exp2f(s[kt][j][r] - mx); s[kt][j][r] = e; ps += e; }
  { auto rr = __builtin_amdgcn_permlane32_swap(__float_as_uint(ps), __float_as_uint(ps), false, false); ps = __uint_as_float(rr[0]) + __uint_as_float(rr[1]); }
  if (hi == 0) li_l[r32] = ps; asm volatile("s_waitcnt lgkmcnt(0)" ::: "memory");
  float rli[16];
#pragma unroll
  for (int r = 0; r < 16; ++r) rli[r] = __builtin_amdgcn_rcpf(li_l[crow(r, hi)]);
  bf16x8 pa[4][4];
#pragma unroll
  for (int kt = 0; kt < 4; ++kt) { PK4(s[kt][0], 0, pa[kt][0]); PK4(s[kt][0], 8, pa[kt][1]); PK4(s[kt][1], 0, pa[kt][2]); PK4(s[kt][1], 8, pa[kt][3]); }
  bf16* Ow = memo + (tok0 + qb * 256 + wid * 32) * D_MODEL + h * 256 + r32;
  f32x16 o[4] = {};
#pragma unroll
  for (int st = 8; st < 16; ++st) {
    if (st + 1 < 16) MLOAD(st + 1);
    pv_d0(o, vb0 + (st & 1) * SHM_T, pa[st & 3][0], pa[st & 3][1], pa[st & 3][2], pa[st & 3][3]);
    if ((st & 3) == 3) {
#pragma unroll
      for (int d0 = 0; d0 < 4; ++d0)
#pragma unroll
        for (int r = 0; r < 16; ++r) { Ow[(long)crow(r, hi) * D_MODEL + ((st >> 2) & 1) * 128 + d0 * 32] = (bf16)(cvtpk(o[d0][r] * rli[r], 0.f) & 0xffffu); o[d0][r] = 0.f; } }
    if (st + 1 < 16) MWRITE(st + 1);
    __syncthreads();
  }
#undef MLOAD
#undef MWRITE
}
#undef PK4
#undef SBAR
}

#define LAS __attribute__((address_space(3)))
typedef unsigned short bf16;
typedef unsigned v4u __attribute__((ext_vector_type(4)));
typedef float f32x4 __attribute__((ext_vector_type(4)));
constexpr int NWAVES = 8, LDS_BYTES = 147456;
constexpr size_t MiB = 1u << 20;
constexpr size_t WS_WIN = 1 * MiB;
constexpr size_t WS_WOTH = 21 * MiB;
constexpr size_t WOTH_STRIDE = 24 * MiB, WO_OFF = 6 * MiB, W1_OFF = 8 * MiB, W2_OFF = 16 * MiB;
constexpr size_t WS_WMKV = 69 * MiB;
constexpr size_t WS_MEMB = 85 * MiB;
constexpr size_t WS_MKV = 89 * MiB;
constexpr size_t WS_XB = 121 * MiB;
constexpr size_t WS_A3 = 153 * MiB;
constexpr size_t WS_MERGED = 249 * MiB;
constexpr size_t WS_PROJ = 281 * MiB;
constexpr size_t WS_END = 601 * MiB;

__device__ __forceinline__ unsigned f2bf(float f) { unsigned u = __builtin_bit_cast(unsigned, f); return (u + 0x7fffu + ((u >> 16) & 1u)) >> 16; }
__device__ __forceinline__ unsigned pk2(float lo, float hi) { return f2bf(lo) | (f2bf(hi) << 16); }
__device__ __forceinline__ float wave_sum(float v) {
#pragma unroll
    for (int o = 1; o < 64; o <<= 1) v += __shfl_xor(v, o);
    return v;
}
__device__ __forceinline__ void transpose_item(const float* __restrict__ W, int K, int N, bf16* __restrict__ WT, LAS float* scr, int item, int lane) {
    const int nblk = N / 32, kb = item / nblk, nb = item % nblk, k0 = 64 * kb, n0 = 32 * nb;
#pragma unroll 8
    for (int i = 0; i < 32; ++i) { const int kk = 2 * i + (lane >> 5); scr[kk * 33 + (lane & 31)] = W[(size_t)(k0 + kk) * N + n0 + (lane & 31)]; }
    asm volatile("s_waitcnt lgkmcnt(0)" ::: "memory");
    const int c = lane & 7;
#pragma unroll
    for (int j = 0; j < 4; ++j) { const int n = (lane >> 3) + 8 * j; const LAS float* s = scr + (8 * c) * 33 + n;
        v4u o; o.x = pk2(s[0 * 33], s[1 * 33]); o.y = pk2(s[2 * 33], s[3 * 33]); o.z = pk2(s[4 * 33], s[5 * 33]); o.w = pk2(s[6 * 33], s[7 * 33]);
        *(v4u*)(WT + (size_t)(n0 + n) * K + k0 + 8 * c) = o; }
    asm volatile("s_waitcnt lgkmcnt(0)" ::: "memory");
}
#define XB_TMO      128
#define XB_XCNT(j)  (256  + 64 * (j))
#define XB_XSUB(j)  (1280 + 64 * (j))
#define XB_XGEN(j)  (2304 + 64 * (j))
#define XB_TOP      3328
#define XB_TOPGEN   3392
#define XCD_BAR_WORDS 3456
#define XB_SPIN_CAP (1u << 18)

__device__ __forceinline__ unsigned xb_ld(unsigned* p)              { return __hip_atomic_load(p, __ATOMIC_RELAXED, __HIP_MEMORY_SCOPE_AGENT); }
__device__ __forceinline__ unsigned xb_add(unsigned* p, unsigned v) { return __hip_atomic_fetch_add(p, v, __ATOMIC_RELAXED, __HIP_MEMORY_SCOPE_AGENT); }
__device__ __forceinline__ unsigned xb_xcc_id() { return (unsigned)__builtin_amdgcn_s_getreg((3 << 11) | 20) & 0xFu; }
#define XB_SPIN(cond, bar) do { unsigned _sp = 0; while (cond) { __builtin_amdgcn_s_sleep(1); \
    if ((++_sp & 255u) == 0u) { if (xb_ld(&(bar)[XB_TMO])) break; if (_sp > XB_SPIN_CAP) { atomicAdd(&(bar)[XB_TMO], 1u); break; } } } } while (0)

struct XcdBarrier {
    unsigned* bar; unsigned x;
    volatile LAS unsigned* st;
};

__device__ __forceinline__ XcdBarrier xcd_barrier_post(unsigned* bar, volatile LAS unsigned* st) {
    XcdBarrier b; b.bar = bar; b.x = xb_xcc_id(); b.st = st;
    if (threadIdx.x == 0) (void)xb_add(&bar[XB_XCNT(b.x)], 1u);
    return b;
}
__device__ __forceinline__ void xcd_barrier_complete(unsigned* bar, unsigned x, unsigned& nloc, unsigned& nx) {
    const unsigned G = gridDim.x * gridDim.y * gridDim.z;
    unsigned sum, cnt, mine, sp = 0u;
    for (;;) {
        sum = 0u; cnt = 0u; mine = 0u;
#pragma unroll
        for (unsigned j = 0; j < 16; ++j) { const unsigned c = xb_ld(&bar[XB_XCNT(j)]); sum += c; cnt += (c > 0u) ? 1u : 0u; mine = (j == x) ? c : mine; }
        if (sum == G) break;
        __builtin_amdgcn_s_sleep(1);
        if ((++sp & 255u) == 0u) { if (xb_ld(&bar[XB_TMO])) break; if (sp > XB_SPIN_CAP) { atomicAdd(&bar[XB_TMO], 1u); break; } }
    }
    nloc = mine > 0u ? mine : 1u; nx = cnt > 0u ? cnt : 1u;
}

__device__ __forceinline__ void xcd_barrier(const XcdBarrier& b) {
    asm volatile("s_waitcnt vmcnt(0)" ::: "memory");
    __syncthreads();
    if (threadIdx.x == 0) {
        unsigned* bar = b.bar;
        __builtin_amdgcn_s_waitcnt(0);
        unsigned nloc = b.st[0], nx = b.st[1];
        if (nloc == 0u) { xcd_barrier_complete(bar, b.x, nloc, nx); b.st[0] = nloc; b.st[1] = nx; }
        const unsigned old = xb_add(&bar[XB_XSUB(b.x)], 1u);
        const unsigned gen = old / nloc;
        if (old + 1u == (gen + 1u) * nloc) {
            __builtin_amdgcn_fence(__ATOMIC_RELEASE, "agent");
            asm volatile("s_waitcnt vmcnt(0)" ::: "memory");
            const unsigned og = xb_add(&bar[XB_TOP], 1u);
            const unsigned tg = og / nx;
            if (og + 1u == (tg + 1u) * nx) xb_add(&bar[XB_TOPGEN], 1u);
            else XB_SPIN(xb_ld(&bar[XB_TOPGEN]) == tg, bar);
            __builtin_amdgcn_fence(__ATOMIC_ACQUIRE, "agent");
            xb_add(&bar[XB_XGEN(b.x)], 1u);
            asm volatile("s_waitcnt vmcnt(0)" ::: "memory");
        } else {
            XB_SPIN(xb_ld(&bar[XB_XGEN(b.x)]) == gen, bar);
            __builtin_amdgcn_fence(__ATOMIC_ACQUIRE, "agent");
            asm volatile("s_waitcnt vmcnt(0)" ::: "memory");
        }
    }
    __syncthreads();
}

struct Args { const float* in[19]; float* out; unsigned char* ws; };
enum { I_X = 0, I_MEM, I_WIN, I_BGATE, I_CONVW, I_WCONVOUT, I_LAMBDA, I_SUBLN, I_WDIFFOUT, I_RELBIAS, I_WMEMKV, I_WMEMOUT, I_WO, I_LN1G, I_LN1B, I_WMLP1, I_WMLP2, I_LN2G, I_LN2B };

__device__ __forceinline__ void convert_layer_weights(const Args& a, int l, LAS float* scr, int gw, int NGW, int lane) {
    unsigned char* ws = a.ws;
    bf16* win_t = (bf16*)(ws + WS_WIN); bf16* oth = (bf16*)(ws + WS_WOTH + (size_t)(l & 1) * WOTH_STRIDE);
    constexpr int I_IN = 16 * 320, I_SQ = 16 * 32, I_1 = 16 * 128, I_2 = 64 * 32, NITEMS = I_IN + 4 * I_SQ + I_1 + I_2;
    for (int it = gw; it < NITEMS; it += NGW) {
        int r = it;
        if (r < I_IN) { transpose_item(a.in[I_WIN] + (size_t)l * 1024 * NIN, 1024, NIN, win_t, scr, r, lane); continue; } r -= I_IN;
        if (r < I_SQ) { transpose_item(a.in[I_WCONVOUT] + (size_t)l * 1048576, 1024, 1024, oth, scr, r, lane); continue; } r -= I_SQ;
        if (r < I_SQ) { transpose_item(a.in[I_WDIFFOUT] + (size_t)l * 1048576, 1024, 1024, oth + 1048576, scr, r, lane); continue; } r -= I_SQ;
        if (r < I_SQ) { transpose_item(a.in[I_WMEMOUT] + (size_t)l * 1048576, 1024, 1024, oth + 2 * 1048576, scr, r, lane); continue; } r -= I_SQ;
        if (r < I_SQ) { transpose_item(a.in[I_WO] + (size_t)l * 1048576, 1024, 1024, (bf16*)((unsigned char*)oth + WO_OFF), scr, r, lane); continue; } r -= I_SQ;
        if (r < I_1) { transpose_item(a.in[I_WMLP1] + (size_t)l * 4194304, 1024, 4096, (bf16*)((unsigned char*)oth + W1_OFF), scr, r, lane); continue; } r -= I_1;
        transpose_item(a.in[I_WMLP2] + (size_t)l * 4194304, 4096, 1024, (bf16*)((unsigned char*)oth + W2_OFF), scr, r, lane);
    }
}
__device__ __forceinline__ void cvt_rows(const float* __restrict__ src, bf16* __restrict__ dst, size_t n8, size_t gt, size_t ngt) {
    for (size_t i = gt; i < n8; i += ngt) { const f32x4 a = *(const f32x4*)(src + i * 8), b = *(const f32x4*)(src + i * 8 + 4);
        v4u o; o.x = pk2(a.x, a.y); o.y = pk2(a.z, a.w); o.z = pk2(b.x, b.y); o.w = pk2(b.z, b.w); *(v4u*)(dst + i * 8) = o; }
}
__device__ __forceinline__ void ln_row(const float* vrow, float* orow, bf16* brow, const float* __restrict__ g, const float* __restrict__ bt, int lane) {
    const f32x4* xr = (const f32x4*)vrow + lane;
    f32x4 v[4]; float s = 0.f;
#pragma unroll
    for (int j = 0; j < 4; ++j) { v[j] = xr[64 * j]; s += (v[j].x + v[j].y) + (v[j].z + v[j].w); }
    const float mean = wave_sum(s) * (1.f / 1024.f); float s2 = 0.f;
#pragma unroll
    for (int j = 0; j < 4; ++j) { v[j] = v[j] - mean; s2 += (v[j].x * v[j].x + v[j].y * v[j].y) + (v[j].z * v[j].z + v[j].w * v[j].w); }
    const float rstd = 1.f / sqrtf(wave_sum(s2) * (1.f / 1024.f) + LN_EPS);
    unsigned long long* o8 = (unsigned long long*)brow + lane; f32x4* of = (f32x4*)orow + lane;
#pragma unroll
    for (int j = 0; j < 4; ++j) { const f32x4 gg = *((const f32x4*)g + lane + 64 * j), bb = *((const f32x4*)bt + lane + 64 * j);
        const f32x4 y = v[j] * rstd * gg + bb; of[64 * j] = y;
        o8[64 * j] = (unsigned long long)pk2(y.x, y.y) | ((unsigned long long)pk2(y.z, y.w) << 32); }
}
__device__ __forceinline__ void bf8_to_f32(const v4u& w, float (&f)[8]) {
    f[0] = __uint_as_float(w.x << 16); f[1] = __uint_as_float(w.x & 0xffff0000u); f[2] = __uint_as_float(w.y << 16); f[3] = __uint_as_float(w.y & 0xffff0000u);
    f[4] = __uint_as_float(w.z << 16); f[5] = __uint_as_float(w.z & 0xffff0000u); f[6] = __uint_as_float(w.w << 16); f[7] = __uint_as_float(w.w & 0xffff0000u); }
__device__ __forceinline__ void conv_phase(const bf16* __restrict__ proj, const float* __restrict__ cw, bf16* __restrict__ ain, size_t gt, size_t ngt) {
    for (size_t idx = gt; idx < (size_t)M_TOK * 128; idx += ngt) {
        const int t = (int)(idx >> 7), c8 = (int)(idx & 127) * 8, s = t & (SEQ - 1);
        const bf16* row = proj + (size_t)t * NIN;
        float y[8], hb[8], cb[8];
#pragma unroll
        for (int e = 0; e < 8; ++e) y[e] = 0.f;
#pragma unroll
        for (int j = 0; j < 3; ++j) {
            const int sj = s + j - 1;
            if (sj >= 0 && sj < SEQ) {
                const bf16* rj = row + (long)(j - 1) * NIN;
                bf8_to_f32(*(const v4u*)(rj + COL_CH + c8), hb); bf8_to_f32(*(const v4u*)(rj + COL_CC + c8), cb);
                const f32x4 w0 = *(const f32x4*)(cw + j * 1024 + c8), w1 = *(const f32x4*)(cw + j * 1024 + c8 + 4);
#pragma unroll
                for (int e = 0; e < 4; ++e) { y[e] += w0[e] * (hb[e] * cb[e]); y[4 + e] += w1[e] * (hb[4 + e] * cb[4 + e]); }
            }
        }
        bf8_to_f32(*(const v4u*)(row + COL_CB + c8), cb);
        v4u o; o.x = pk2(cb[0] * y[0], cb[1] * y[1]); o.y = pk2(cb[2] * y[2], cb[3] * y[3]); o.z = pk2(cb[4] * y[4], cb[5] * y[5]); o.w = pk2(cb[6] * y[6], cb[7] * y[7]);
        *(v4u*)(ain + (size_t)t * D_MODEL + c8) = o;
    }
}

__global__ void __launch_bounds__(NWAVES * 64, 2) fwd_megakernel(Args a) {
    extern __shared__ __attribute__((aligned(16))) unsigned char lds[];
    cg::grid_group grid = cg::this_grid();
    const int G = gridDim.x, bx = blockIdx.x, vcu = (G % 8 == 0) ? (bx % 8) * (G / 8) + bx / 8 : bx;
    const int NGW = G * NWAVES; const size_t ngt = (size_t)G * NWAVES * 64;
#define FRESH_TID() int tid = threadIdx.x; asm volatile("" : "+v"(tid)); const int lane = tid & 63, wave = __builtin_amdgcn_readfirstlane(tid >> 6); const int gw = vcu * NWAVES + wave; const size_t gt = (size_t)bx * (NWAVES * 64) + tid; LAS float* scr = (LAS float*)(ldsl + wave * 16384); (void)lane; (void)gw; (void)gt; (void)scr
    unsigned char* ws = a.ws;
    LAS unsigned char* ldsl = (LAS unsigned char*)lds;
    bf16* win_t = (bf16*)(ws + WS_WIN); bf16* wmkv_t = (bf16*)(ws + WS_WMKV); bf16* memb = (bf16*)(ws + WS_MEMB); bf16* mkv = (bf16*)(ws + WS_MKV);
    bf16* xb = (bf16*)(ws + WS_XB); bf16* a3 = (bf16*)(ws + WS_A3); bf16* merged = (bf16*)(ws + WS_MERGED); bf16* proj = (bf16*)(ws + WS_PROJ); bf16* hbuf = proj;
    float* out = a.out;
    volatile LAS unsigned* MISC = (volatile LAS unsigned*)(ldsl + 131072);
    if (threadIdx.x < 64) MISC[threadIdx.x] = 0u;
    __syncthreads();
    XcdBarrier bar = xcd_barrier_post((unsigned*)ws + 4096, MISC + 8);

    { FRESH_TID();
    convert_layer_weights(a, 0, scr, gw, NGW, lane);
    for (int it = gw; it < DEPTH * 16 * 64; it += NGW) { const int l = it / 1024, r = it % 1024;
        transpose_item(a.in[I_WMEMKV] + (size_t)l * 1024 * 2048, 1024, 2048, wmkv_t + (size_t)l * 2048 * 1024, scr, r, lane); }
    cvt_rows(a.in[I_X], xb, (size_t)M_TOK * 1024 / 8, gt, ngt);
    cvt_rows(a.in[I_MEM], memb, (size_t)BATCH * MEM_LEN * 1024 / 8, gt, ngt);
    }
    grid.sync();
    {
        pg8::Gemm g{memb, wmkv_t, BATCH * MEM_LEN, DEPTH * 2048, 1024}; pg8::StaticOrder S; S.init(BATCH * MEM_LEN, DEPTH * 2048, G, bx);
        pg8::EpiBf16<0> E{mkv, MKV_LD};

#ifndef NO_G0
            pg8::gemm_phase<pg8::EpiBf16<0>, pg8::StaticOrder, true, true>(ldsl, g, S, E);
#endif

    }
#pragma unroll 1
    for (int l = 0; l < DEPTH; ++l) {
        bf16* oth = (bf16*)(ws + WS_WOTH + (size_t)(l & 1) * WOTH_STRIDE);
        const float lam_init = 0.8f - 0.6f * expf(-0.3f * (float)l);
        {
            pg8::Gemm g{xb, win_t, M_TOK, NIN, 1024}; pg8::StaticOrder S; S.init(M_TOK, NIN, G, bx);
            pg8::EpiProj E{proj, NIN, a.in[I_BGATE] + (size_t)l * 3072, 0.125f * LOG2E, 0.0625f * LOG2E};

#ifndef NO_GA
            pg8::gemm_phase<pg8::EpiProj, pg8::StaticOrder, true, true>(ldsl, g, S, E);
#endif

        }
        xcd_barrier(bar);
        {   FRESH_TID();
            conv_phase(proj, a.in[I_CONVW] + (size_t)l * 3072, a3, gt, ngt);
            float* misc = (float*)(lds + att::LDS_MISC);
            if (tid == 0) { const float* lp = a.in[I_LAMBDA] + (size_t)l * 256; float s01 = 0.f, s23 = 0.f;
                for (int i = 0; i < 64; ++i) { s01 += lp[i] * lp[64 + i]; s23 += lp[128 + i] * lp[192 + i]; }
                misc[0] = expf(s01) - expf(s23) + lam_init; }
            __syncthreads();
            const float lam = misc[0];
#ifndef NO_DIFF
            for (int i = 0; i < 4; ++i) { const int id = vcu * 4 + i; if (id >= 1024) break;
                att::diff_unit(proj, a3 + (size_t)M_TOK * 1024, (id >> 4) >> 3, (id >> 4) & 7, id & 15, lam, 1.f - lam_init, a.in[I_SUBLN] + (size_t)l * 128, a.in[I_RELBIAS], (char*)lds); }
#endif
#ifndef NO_MEM
            { const int id = vcu; if (id < 256) att::mem_unit(proj, mkv + (size_t)l * 2048, a3 + (size_t)2 * M_TOK * 1024, (id >> 3) >> 2, (id >> 3) & 3, id & 7, (char*)lds); }
#endif
            __syncthreads();
            if (l + 1 < DEPTH) convert_layer_weights(a, l + 1, scr, gw, NGW, lane);
        }
        xcd_barrier(bar);
        {
            pg8::Gemm g{a3, oth, 3 * M_TOK, 3 * 1024, 1024}; pg8::MergeOrder S; S.init(M_TOK, 1024, G, bx);
            pg8::EpiMerge E{proj + COL_GL, NIN, merged, 1024};

#ifndef NO_GC
            pg8::gemm_phase<pg8::EpiMerge, pg8::MergeOrder, true, true>(ldsl, g, S, E);
#endif

        }
        xcd_barrier(bar);
        {
            pg8::Gemm g{merged, (bf16*)((unsigned char*)oth + WO_OFF), M_TOK, 1024, 1024}; pg8::StaticOrder S; S.init(M_TOK, 1024, G, bx);
            pg8::EpiResid E{l == 0 ? a.in[I_X] : out, out, 1024, DN_ALPHA};

#ifndef NO_GD
            pg8::gemm_phase<pg8::EpiResid, pg8::StaticOrder, true, true>(ldsl, g, S, E);
#endif

        }
        xcd_barrier(bar);
        { FRESH_TID(); for (int m = gw; m < M_TOK; m += NGW) ln_row(out + (size_t)m * 1024, out + (size_t)m * 1024, xb + (size_t)m * 1024, a.in[I_LN1G] + (size_t)l * 1024, a.in[I_LN1B] + (size_t)l * 1024, lane); }
        xcd_barrier(bar);
        {
            pg8::Gemm g{xb, (bf16*)((unsigned char*)oth + W1_OFF), M_TOK, D_FF, 1024}; pg8::StaticOrder S; S.init(M_TOK, D_FF, G, bx);
            pg8::EpiBf16<1> E{hbuf, D_FF};

#ifndef NO_GE
            pg8::gemm_phase<pg8::EpiBf16<1>, pg8::StaticOrder, true, true>(ldsl, g, S, E);
#endif

        }
        xcd_barrier(bar);
        {
            pg8::Gemm g{hbuf, (bf16*)((unsigned char*)oth + W2_OFF), M_TOK, 1024, D_FF}; pg8::StaticOrder S; S.init(M_TOK, 1024, G, bx);
            pg8::EpiResid E{out, out, 1024, DN_ALPHA};

#ifndef NO_GD
            pg8::gemm_phase<pg8::EpiResid, pg8::StaticOrder, true, true>(ldsl, g, S, E);
#endif

        }
        xcd_barrier(bar);
        { FRESH_TID(); for (int m = gw; m < M_TOK; m += NGW) ln_row(out + (size_t)m * 1024, out + (size_t)m * 1024, xb + (size_t)m * 1024, a.in[I_LN2G] + (size_t)l * 1024, a.in[I_LN2B] + (size_t)l * 1024, lane); }
        xcd_barrier(bar);
    }
}

extern "C" void kernel_launch(void* const* d_in, const int* in_sizes, int n_in, void* d_out, int out_size, void* d_ws, size_t ws_size, hipStream_t stream) {
    static int grid = 0;
    if (grid == 0) {
        if (n_in != 19 || in_sizes[0] != M_TOK * 1024 || out_size != M_TOK * 1024 || ws_size < WS_END) {
            fprintf(stderr, "kernel_launch: unexpected shapes: n_in %d in0 %d out %d ws %zu (need >= %zu)\n", n_in, n_in > 0 ? in_sizes[0] : -1, out_size, ws_size, (size_t)WS_END); grid = -1; return; }
        int dev = 0, cus = 0, per_cu = 0;
        hipGetDevice(&dev); hipDeviceGetAttribute(&cus, hipDeviceAttributeMultiprocessorCount, dev);
        if (hipFuncSetAttribute((const void*)fwd_megakernel, hipFuncAttributeMaxDynamicSharedMemorySize, LDS_BYTES) != hipSuccess) { fprintf(stderr, "kernel_launch: hipFuncSetAttribute failed\n"); grid = -1; return; }
        if (hipOccupancyMaxActiveBlocksPerMultiprocessor(&per_cu, (const void*)fwd_megakernel, NWAVES * 64, LDS_BYTES) != hipSuccess || per_cu < 1) { fprintf(stderr, "kernel_launch: occupancy query says %d blocks per CU\n", per_cu); per_cu = 1; }
        (void)hipGetLastError();
        grid = cus;
        if (grid != 256) fprintf(stderr, "kernel_launch: %d CUs: this kernel is laid out for 256\n", grid);
    }
    if (grid < 0) return;
    if (hipMemsetAsync(d_ws, 0, 65536, stream) != hipSuccess) { fprintf(stderr, "kernel_launch: memset failed\n"); return; }
    Args a{};
    for (int i = 0; i < 19; ++i) a.in[i] = (const float*)d_in[i];
    a.out = (float*)d_out; a.ws = (unsigned char*)d_ws;
    void* args[] = {&a};
    hipError_t e = hipLaunchCooperativeKernel((const void*)fwd_megakernel, dim3(grid), dim3(NWAVES * 64), args, LDS_BYTES, stream);
    if (e != hipSuccess) fprintf(stderr, "kernel_launch: cooperative launch failed: %s (grid %d)\n", hipGetErrorString(e), grid);
}
```
